# Optimizing an MI355X kernel written in HIP

```python
import jax, jax.numpy as jnp
from jax import lax
import numpy as np

D_MODEL = 2048
BATCH = 4
SEQ = 2048
DEPTH = 1

CHUNK = 64
H_A = 8
DK_A = 128
DV_A = 128
D_A = H_A * DK_A
H_B = 8
DH_B = 128
D_B = H_B * DH_B
N_PAST_CHUNKS = 8
BAND = N_PAST_CHUNKS + 1
REL_FUTURE = CHUNK - 1
REL_PAST = 2 * CHUNK - 1
N_REL = REL_FUTURE + REL_PAST + 1
D_FF = -(-8 * D_MODEL // (3 * 256)) * 256
N_IN = 4 * D_A + 3 * D_B + 2 * D_MODEL
EPS = 1e-6

kernel_name = "hybrid_hgrn2_chunkattn_gated_block"


def rms_norm(x, gain):
    xf = x.astype(jnp.float32)
    y = xf * lax.rsqrt(jnp.mean(xf * xf, axis=-1, keepdims=True) + EPS)
    return (y * gain.astype(jnp.float32)).astype(x.dtype)


def hgrn_lower_bounds(lb_logits):
    p = jax.nn.softmax(lb_logits.astype(jnp.float32), axis=0)
    return jnp.cumsum(p, axis=0)[:DEPTH]


def hgrn2_mixer(q, f_logit, i, g, lb, out_gain):
    B, T, _ = q.shape
    n_chunks = T // CHUNK
    f32 = jnp.float32
    lbf = lb.astype(f32)
    f = lbf + (1.0 - lbf) * jax.nn.sigmoid(f_logit.astype(f32))
    log_f = jnp.log(f)
    k = 1.0 - f
    qs = jax.nn.silu(q.astype(f32))

    def to_chunks(t, dh):
        return t.reshape(B, n_chunks, CHUNK, H_A, dh).transpose(1, 0, 3, 2, 4)

    qc, kc, lfc = to_chunks(qs, DK_A), to_chunks(k, DK_A), to_chunks(log_f, DK_A)
    vc = to_chunks(i.astype(f32), DV_A)
    causal = jnp.tril(jnp.ones((CHUNK, CHUNK), dtype=bool))[:, :, None]

    def step(S, inp):
        qj, kj, lfj, vj = inp
        b = jnp.cumsum(lfj, axis=2)
        o_inter = jnp.einsum('bhtk,bhkv->bhtv', qj * jnp.exp(b), S)
        rel = jnp.where(causal, b[:, :, :, None, :] - b[:, :, None, :, :], -jnp.inf)
        decay = jnp.exp(rel)
        scores = jnp.einsum('bhtk,bhsk,bhtsk->bhts', qj, kj, decay)
        o_intra = jnp.einsum('bhts,bhsv->bhtv', scores, vj)
        b_last = b[:, :, -1:, :]
        S_new = jnp.exp(b_last[:, :, 0, :, None]) * S + jnp.einsum(
            'bhsk,bhsv->bhkv', kj * jnp.exp(b_last - b), vj)
        return S_new, o_inter + o_intra

    S0 = jnp.zeros((B, H_A, DK_A, DV_A), f32)
    _, o = lax.scan(step, S0, (qc, kc, lfc, vc))
    o = o.transpose(1, 0, 3, 2, 4).reshape(B, T, H_A, DV_A)
    o = o * lax.rsqrt(jnp.mean(o * o, axis=-1, keepdims=True) + EPS)
    o = o.reshape(B, T, D_A) * out_gain.astype(f32)
    o = o * jax.nn.silu(g.astype(f32))
    return o.astype(q.dtype)


def head_rms_norm(t, gain):
    tf = t.astype(jnp.float32)
    y = tf * lax.rsqrt(jnp.mean(tf * tf, axis=-1, keepdims=True) + EPS)
    return y * gain.astype(jnp.float32)


def chunked_relpos_attention(q, k, v, q_gain, k_gain, rel_bias):
    B, T, _ = q.shape
    n_chunks = T // CHUNK

    def heads(t):
        return t.reshape(B, n_chunks, CHUNK, H_B, DH_B).transpose(0, 3, 1, 2, 4)

    qh = head_rms_norm(heads(q), q_gain)
    kh = head_rms_norm(heads(k), k_gain)
    vh = heads(v).astype(jnp.float32)

    pad = ((0, 0), (0, 0), (N_PAST_CHUNKS, 0), (0, 0), (0, 0))
    band_idx = jnp.arange(n_chunks)[:, None] + jnp.arange(BAND)[None, :]
    k_band = jnp.pad(kh, pad)[:, :, band_idx].reshape(B, H_B, n_chunks, BAND * CHUNK, DH_B)
    v_band = jnp.pad(vh, pad)[:, :, band_idx].reshape(B, H_B, n_chunks, BAND * CHUNK, DH_B)

    q_pos = jnp.arange(n_chunks)[:, None] * CHUNK + jnp.arange(CHUNK)[None, :]
    k_chunk = band_idx - N_PAST_CHUNKS
    k_pos = (k_chunk[:, :, None] * CHUNK + jnp.arange(CHUNK)[None, None, :]).reshape(
        n_chunks, BAND * CHUNK)
    valid = k_pos >= 0
    dist = q_pos[:, :, None] - k_pos[:, None, :]
    rel_idx = jnp.clip(dist, -REL_FUTURE, REL_PAST) + REL_FUTURE
    bias = rel_bias.astype(jnp.float32)[:, rel_idx]

    scale = DH_B ** -0.5
    scores = jnp.einsum('bhnqd,bhnkd->bhnqk', qh, k_band) * scale + bias[None]
    scores = jnp.where(valid[None, None, :, None, :], scores, -jnp.inf)
    p = jax.nn.softmax(scores, axis=-1)
    o = jnp.einsum('bhnqk,bhnkd->bhnqd', p, v_band)
    return o.transpose(0, 2, 3, 1, 4).reshape(B, T, D_B).astype(q.dtype)


def setup_inputs(seed: int = 0) -> dict:
    key = jax.random.key(seed)
    ks = jax.random.split(key, 16)
    f32 = jnp.float32

    def nrm(k, shape, scale):
        return jax.random.normal(k, shape, f32) * scale

    return {
        "x": nrm(ks[0], (BATCH, SEQ, D_MODEL), 1.0),
        "w_in": nrm(ks[1], (DEPTH, D_MODEL, N_IN), D_MODEL ** -0.5),
        "b_gate": nrm(ks[2], (DEPTH, 2 * D_MODEL), 0.02),
        "norm_mix": 1.0 + nrm(ks[3], (DEPTH, D_MODEL), 0.02),
        "norm_ffn": 1.0 + nrm(ks[4], (DEPTH, D_MODEL), 0.02),
        "hgrn_lb_logits": nrm(ks[5], (DEPTH + 1, D_A), 0.5),
        "hgrn_out_gain": 1.0 + nrm(ks[6], (DEPTH, D_A), 0.02),
        "q_gain": 1.0 + nrm(ks[7], (DEPTH, DH_B), 0.02),
        "k_gain": 1.0 + nrm(ks[8], (DEPTH, DH_B), 0.02),
        "rel_bias": nrm(ks[9], (DEPTH, H_B, N_REL), 0.1),
        "w_proj_a": nrm(ks[10], (DEPTH, D_A, D_MODEL), D_A ** -0.5),
        "w_proj_b": nrm(ks[11], (DEPTH, D_B, D_MODEL), D_B ** -0.5),
        "w_out": nrm(ks[12], (DEPTH, D_MODEL, D_MODEL), D_MODEL ** -0.5),
        "w_ffn_in": nrm(ks[13], (DEPTH, D_MODEL, 2 * D_FF), D_MODEL ** -0.5),
        "w_ffn_out": nrm(ks[14], (DEPTH, D_FF, D_MODEL), D_FF ** -0.5),
    }


def reference(x, w_in, b_gate, norm_mix, norm_ffn, hgrn_lb_logits, hgrn_out_gain,
              q_gain, k_gain, rel_bias, w_proj_a, w_proj_b, w_out, w_ffn_in, w_ffn_out):
    lower_bounds = hgrn_lower_bounds(hgrn_lb_logits)
    split_pts = [D_A, 2 * D_A, 3 * D_A, 4 * D_A,
                 4 * D_A + D_B, 4 * D_A + 2 * D_B, 4 * D_A + 3 * D_B]
    for l in range(DEPTH):
        h = rms_norm(x, norm_mix[l])
        proj = jnp.einsum('btd,dn->btn', h, w_in[l])
        q_a, f_a, i_a, g_a, q_b, k_b, v_b, gate_logits = jnp.split(proj, split_pts, axis=-1)
        gates = jax.nn.sigmoid((gate_logits + b_gate[l]).astype(jnp.float32)).astype(x.dtype)
        gate_a, gate_b = jnp.split(gates, 2, axis=-1)

        y_a = hgrn2_mixer(q_a, f_a, i_a, g_a, lower_bounds[l], hgrn_out_gain[l])
        y_b = chunked_relpos_attention(q_b, k_b, v_b, q_gain[l], k_gain[l], rel_bias[l])

        merged = (gate_a * jnp.einsum('btc,cd->btd', y_a, w_proj_a[l])
                  + gate_b * jnp.einsum('btc,cd->btd', y_b, w_proj_b[l]))
        x = x + jnp.einsum('btd,de->bte', merged, w_out[l])

        h = rms_norm(x, norm_ffn[l])
        gate_up = jnp.einsum('btd,df->btf', h, w_ffn_in[l])
        ff_gate, ff_up = jnp.split(gate_up, 2, axis=-1)
        x = x + jnp.einsum('btf,fd->btd', jax.nn.silu(ff_gate) * ff_up, w_ffn_out[l])
    return x
```

```cpp
#include <hip/hip_runtime.h>
#include <hip/hip_cooperative_groups.h>
#include <cstdio>
namespace cg = cooperative_groups;

#define LAS __attribute__((address_space(3)))
#define DI __device__ __forceinline__
typedef unsigned short bf16_t;
typedef short bf16x8 __attribute__((ext_vector_type(8)));
typedef float f32x4 __attribute__((ext_vector_type(4)));
typedef float f32x2 __attribute__((ext_vector_type(2)));
typedef unsigned u32x4 __attribute__((ext_vector_type(4)));
typedef unsigned u32x2 __attribute__((ext_vector_type(2)));
typedef __bf16 bf16x2_t __attribute__((ext_vector_type(2)));

constexpr int MTOK = 8192, DM = 2048, NIN = 11264, DFF = 5632, DA = 1024, SEQ = 2048;
constexpr float EPS = 1e-6f;
constexpr size_t MiB = 1u << 20;
constexpr size_t WS_CTL = 0;
constexpr size_t WS_WIN = 1 * MiB;
constexpr size_t WS_YA = 1 * MiB, WS_YB = 17 * MiB, WS_X1B = 1 * MiB;
constexpr size_t WS_WPA = 45 * MiB, WS_WPB = 49 * MiB, WS_WO = 53 * MiB, WS_WF1 = 61 * MiB, WS_WF2 = 105 * MiB;
constexpr size_t WS_QS = 127 * MiB, WS_KK = 143 * MiB, WS_VI = 159 * MiB, WS_SG = 175 * MiB, WS_LOGF = 191 * MiB;
constexpr size_t WS_QB = 223 * MiB, WS_KB = 239 * MiB, WS_VB = 255 * MiB, WS_GA = 271 * MiB, WS_GB = 303 * MiB, WS_QEG = 335 * MiB, WS_END = 351 * MiB;
constexpr size_t WS_EV = 33 * MiB;
constexpr size_t WS_SSC = 191 * MiB;
constexpr size_t WS_QCTR = 131072 - 256;
constexpr size_t OUT_OI = 0, OUT_U = 32 * MiB;
constexpr size_t WS_MERGED = 127 * MiB;
constexpr size_t WS_ACT = 159 * MiB;
constexpr int LDS_BYTES = 131072;
#ifndef PROBE_DUP
#define PROBE_DUP -1
#endif


struct Params { const float* in[15]; float* out; unsigned char* ws; int ph_lo, ph_hi; };

DI unsigned pk2(float lo, float hi) { f32x2 v = {lo, hi}; bf16x2_t b = __builtin_convertvector(v, bf16x2_t); return __builtin_bit_cast(unsigned, b); }
typedef _Float16 f16x2_t __attribute__((ext_vector_type(2)));
DI unsigned pkh2(float a, float b) { f16x2_t v = {(_Float16)a, (_Float16)b}; return __builtin_bit_cast(unsigned, v); }
DI float bflo(unsigned u) { return __uint_as_float(u << 16); }
DI float bfhi(unsigned u) { return __uint_as_float(u & 0xffff0000u); }
DI float bf2f(bf16_t b) { return __uint_as_float(((unsigned)b) << 16); }
DI float sigm(float x) { return __builtin_amdgcn_rcpf(1.f + __expf(-x)); }
DI float silu(float x) { return x * sigm(x); }
#define MFMA16(a, b, c) __builtin_amdgcn_mfma_f32_16x16x32_bf16((a), (b), (c), 0, 0, 0)


#define XB_TMO      128
#define XB_XCNT(j)  (256  + 64 * (j))
#define XB_XSUB(j)  (1280 + 64 * (j))
#define XB_XGEN(j)  (2304 + 64 * (j))
#define XB_TOP      3328
#define XB_TOPGEN   3392
#define XCD_BAR_WORDS 3456
#define XB_SPIN_CAP (1u << 18)
DI unsigned xb_ld(unsigned* p)              { return __hip_atomic_load(p, __ATOMIC_RELAXED, __HIP_MEMORY_SCOPE_AGENT); }
DI unsigned xb_add(unsigned* p, unsigned v) { return __hip_atomic_fetch_add(p, v, __ATOMIC_RELAXED, __HIP_MEMORY_SCOPE_AGENT); }
DI unsigned xb_xcc_id() { return (unsigned)__builtin_amdgcn_s_getreg((3 << 11) | 20) & 0xFu; }
#define XB_SPIN(cond, bar) do { unsigned _sp = 0; while (cond) { __builtin_amdgcn_s_sleep(1); \
    if ((++_sp & 255u) == 0u) { if (xb_ld(&(bar)[XB_TMO])) break; if (_sp > XB_SPIN_CAP) { atomicAdd(&(bar)[XB_TMO], 1u); break; } } } } while (0)
struct XcdBarrier { unsigned* bar; unsigned x; volatile LAS unsigned* st; };
DI XcdBarrier xcd_barrier_post(unsigned* bar, volatile LAS unsigned* st) {
    XcdBarrier b; b.bar = bar; b.x = xb_xcc_id(); b.st = st;
    if (threadIdx.x == 0) (void)xb_add(&bar[XB_XCNT(b.x)], 1u);
    return b;
}
DI void xcd_barrier_complete(unsigned* bar, unsigned x, unsigned& nloc, unsigned& nx) {
    const unsigned G = gridDim.x * gridDim.y * gridDim.z;
    unsigned sum, cnt, mine, sp = 0u;
    for (;;) {
        sum = 0u; cnt = 0u; mine = 0u;
#pragma unroll
        for (unsigned j = 0; j < 16; ++j) { const unsigned c = xb_ld(&bar[XB_XCNT(j)]); sum += c; cnt += (c > 0u) ? 1u : 0u; mine = (j == x) ? c : mine; }
        if (sum == G) break;
        __builtin_amdgcn_s_sleep(1);
        if ((++sp & 255u) == 0u) { if (xb_ld(&bar[XB_TMO])) break; if (sp > XB_SPIN_CAP) { atomicAdd(&bar[XB_TMO], 1u); break; } }
    }
    nloc = mine > 0u ? mine : 1u; nx = cnt > 0u ? cnt : 1u;
}
DI void xcd_barrier(const XcdBarrier& b) {
    asm volatile("s_waitcnt vmcnt(0)" ::: "memory");
    __syncthreads();
    if (threadIdx.x == 0) {
        unsigned* bar = b.bar;
        __builtin_amdgcn_s_waitcnt(0);
        unsigned nloc = b.st[0], nx = b.st[1];
        if (nloc == 0u) { xcd_barrier_complete(bar, b.x, nloc, nx); b.st[0] = nloc; b.st[1] = nx; }
        const unsigned old = xb_add(&bar[XB_XSUB(b.x)], 1u);
        const unsigned gen = old / nloc;
        if (old + 1u == (gen + 1u) * nloc) {
            __builtin_amdgcn_fence(__ATOMIC_RELEASE, "agent");
            asm volatile("s_waitcnt vmcnt(0)" ::: "memory");
            const unsigned og = xb_add(&bar[XB_TOP], 1u);
            const unsigned tg = og / nx;
            if (og + 1u == (tg + 1u) * nx) xb_add(&bar[XB_TOPGEN], 1u);
            else XB_SPIN(xb_ld(&bar[XB_TOPGEN]) == tg, bar);
            __builtin_amdgcn_fence(__ATOMIC_ACQUIRE, "agent");
            xb_add(&bar[XB_XGEN(b.x)], 1u);
            asm volatile("s_waitcnt vmcnt(0)" ::: "memory");
        } else {
            XB_SPIN(xb_ld(&bar[XB_XGEN(b.x)]) == gen, bar);
            __builtin_amdgcn_fence(__ATOMIC_ACQUIRE, "agent");
            asm volatile("s_waitcnt vmcnt(0)" ::: "memory");
        }
    }
    __syncthreads();
}
constexpr size_t WS_BAR = 65536;

namespace pg8 {
constexpr int BM = 256, BK = 64, HALF = 128, HTB = HALF * BK * 2, STAGE_BYTES = 8 * HTB;
DI int lds_byte(int r, int c) { const int st = (r >> 4) * 2 + (c >> 5), rr = r & 15, cc = c & 31, ob = rr * 64 + cc * 2; return st * 1024 + (ob ^ (((ob >> 9) & 1) << 5)); }
DI void stage_rc(int b, int& R, int& C) { const int st = b / 1024, sb = b % 1024, swz = sb ^ (((sb >> 9) & 1) << 5); R = (st >> 1) * 16 + swz / 64; C = (st & 1) * 32 + (swz % 64) / 2; }
DI int perm32(int rho) { const int n = rho >> 4, i = rho & 15; return 8 * (i >> 2) + 4 * n + (i & 3); }
struct Unit { const char* A; const char* B; int pm, pn, sub; };
DI void tile_of(int L, int nM, int nN, int& pm, int& pn) {
    const int nwg = nM * nN; int wgid = L;
    { const int q = nwg / 8, r = nwg % 8, xcd = wgid % 8, off = wgid / 8; wgid = (xcd < r ? xcd * (q + 1) : r * (q + 1) + (xcd - r) * q) + off; }
    const int nig = 8 * nN, gid = wgid / nig, fm = gid * 8, gsz = (nM - fm) < 8 ? (nM - fm) : 8;
    pm = fm + ((wgid % nig) % gsz); pn = (wgid % nig) / gsz;
}
struct SchedPlain {
    const char* A; const char* Bt; int nM, nN, K, G, c;
    DI bool next(int i, Unit& u) const {
        const long L = (long)i * G + c; if (L >= (long)nM * nN) return false;
        tile_of((int)L, nM, nN, u.pm, u.pn); u.sub = 0;
        u.A = A + (size_t)u.pm * 256 * K * 2; u.B = Bt + (size_t)u.pn * 256 * K * 2; return true;
    }
};
struct SchedDual {
    const char *A0, *B0, *A1, *B1; int nM, nN, K, G, c;
    DI bool next(int i, Unit& u) const {
        const long L = (long)(i >> 1) * G + c; if (L >= (long)nM * nN) return false;
        tile_of((int)L, nM, nN, u.pm, u.pn); u.sub = i & 1;
        u.A = (u.sub ? A1 : A0) + (size_t)u.pm * 256 * K * 2; u.B = (u.sub ? B1 : B0) + (size_t)u.pn * 256 * K * 2; return true;
    }
};

template <class Epi, class Sched>
DI void gemm_phase(LAS unsigned char* lds, const int K, const Sched& S, const Epi& E) {
    const int tid = threadIdx.x, wid = __builtin_amdgcn_readfirstlane(tid >> 6), lane = tid & 63, wr = wid >> 2, wc = wid & 3, fr = lane & 15, fq = lane >> 4;
    const int nt = K / BK;
    unsigned voffA[2], voffB[2];
#pragma unroll
    for (int i = 0; i < 2; ++i) { int R, C; stage_rc(tid * 16 + i * 8192, R, C); const int Rb = (R & ~31) + perm32(R & 31);
        voffA[i] = (unsigned)(R * K + C) * 2u; voffB[i] = (unsigned)(Rb * K + C) * 2u; }
    const size_t kstep = (size_t)(BK * 2);
    const size_t hstep = (size_t)HALF * K * 2;
    const unsigned ldsw = (unsigned)wid * 1024u;
    const int aoff = lds_byte(wr * 64 + fr, fq * 8), boff = lds_byte(wc * 32 + fr, fq * 8);
#define PG8_SA(b, h) (((b) * 2 + (h)) * HTB)
#define PG8_SB(b, h) ((4 + (b) * 2 + (h)) * HTB)
#define PG8_STAGE(bufoff, gbase, voff) do { _Pragma("unroll") for (int _i = 0; _i < 2; ++_i) \
        __builtin_amdgcn_global_load_lds((const unsigned*)((const char*)(gbase) + (voff)[_i]), (LAS unsigned*)(lds + (bufoff) + ldsw + _i * 8192), 16, 0, 0); } while (0)
#define PG8_LDA(dst, b, h) do { _Pragma("unroll") for (int m = 0; m < 4; ++m) _Pragma("unroll") for (int k = 0; k < 2; ++k) dst[m][k] = *(const LAS bf16x8*)(lds + PG8_SA(b, h) + aoff + m * 2048 + k * 1024); } while (0)
#define PG8_LDB(dst, b, h) do { _Pragma("unroll") for (int n = 0; n < 2; ++n) _Pragma("unroll") for (int k = 0; k < 2; ++k) dst[n][k] = *(const LAS bf16x8*)(lds + PG8_SB(b, h) + boff + n * 2048 + k * 1024); } while (0)
#define PG8_MMA(ai, bj, At, Bt) do { __builtin_amdgcn_s_setprio(1); _Pragma("unroll") for (int m = 0; m < 4; ++m) _Pragma("unroll") for (int n = 0; n < 2; ++n) _Pragma("unroll") for (int k = 0; k < 2; ++k) \
        acc[ai][bj][m][n] = __builtin_amdgcn_mfma_f32_16x16x32_bf16(Bt[n][k], At[m][k], acc[ai][bj][m][n], 0, 0, 0); __builtin_amdgcn_s_setprio(0); } while (0)
#define PG8_WAIT_V(n) asm volatile("s_waitcnt vmcnt(" #n ")" ::: "memory")
#define PG8_WAIT_L(n) asm volatile("s_waitcnt lgkmcnt(" #n ")" ::: "memory")
#define PG8_BAR __builtin_amdgcn_s_barrier()
#define PG8_SCHED __builtin_amdgcn_sched_barrier(0)
    Unit cur, nxt; int ui = 0;
    if (!S.next(0, cur)) return;
    f32x4 acc[2][2][4][2];
#pragma unroll
    for (int a = 0; a < 2; ++a)
#pragma unroll
        for (int b = 0; b < 2; ++b)
#pragma unroll
            for (int m = 0; m < 4; ++m)
#pragma unroll
                for (int n = 0; n < 2; ++n) acc[a][b][m][n] = (f32x4){0.f, 0.f, 0.f, 0.f};
    bf16x8 At[4][2], B0[2][2], B1[2][2];
    const char* cA = cur.A; const char* cB = cur.B;
    PG8_STAGE(PG8_SB(0, 0), cB, voffB); PG8_STAGE(PG8_SA(0, 0), cA, voffA); PG8_STAGE(PG8_SB(0, 1), cB + hstep, voffB); PG8_STAGE(PG8_SA(0, 1), cA + hstep, voffA);
    if (wr == 1) PG8_BAR;
    PG8_WAIT_V(4); PG8_BAR;
    PG8_STAGE(PG8_SB(1, 0), cB + kstep, voffB); PG8_STAGE(PG8_SA(1, 0), cA + kstep, voffA); PG8_STAGE(PG8_SB(1, 1), cB + hstep + kstep, voffB);
    PG8_WAIT_V(6); PG8_BAR;
    for (;;) {
        const bool has_next = S.next(ui + 1, nxt);
        const char* nA = has_next ? nxt.A : cA; const char* nB = has_next ? nxt.B : cB;
        for (int t = 0; t < nt; t += 2) {
            const bool last = (t == nt - 2);
            const char* a1 = cA + (size_t)(t + 1) * kstep;
            const char* a2 = last ? nA : cA + (size_t)(t + 2) * kstep; const char* b2 = last ? nB : cB + (size_t)(t + 2) * kstep;
            const char* a3 = a2 + kstep; const char* b3 = b2 + kstep;
            PG8_LDB(B0, 0, 0); PG8_SCHED; PG8_LDA(At, 0, 0); PG8_STAGE(PG8_SA(1, 1), a1 + hstep, voffA);
            PG8_WAIT_L(8); PG8_BAR; PG8_WAIT_L(0); PG8_MMA(0, 0, At, B0); PG8_BAR; PG8_SCHED;
            PG8_LDB(B1, 0, 1); PG8_STAGE(PG8_SB(0, 0), b2, voffB);
            PG8_BAR; PG8_WAIT_L(0); PG8_MMA(0, 1, At, B1); PG8_BAR;
            PG8_LDA(At, 0, 1); PG8_STAGE(PG8_SA(0, 0), a2, voffA);
            PG8_BAR; PG8_WAIT_L(0); PG8_MMA(1, 0, At, B0); PG8_BAR; PG8_SCHED;
            PG8_STAGE(PG8_SB(0, 1), b2 + hstep, voffB);
            PG8_WAIT_V(6); PG8_BAR; PG8_MMA(1, 1, At, B1); PG8_BAR;
            PG8_LDB(B0, 1, 0); PG8_SCHED; PG8_LDA(At, 1, 0); PG8_STAGE(PG8_SA(0, 1), a2 + hstep, voffA);
            PG8_WAIT_L(8); PG8_BAR; PG8_WAIT_L(0); PG8_MMA(0, 0, At, B0); PG8_BAR; PG8_SCHED;
            PG8_LDB(B1, 1, 1); PG8_STAGE(PG8_SB(1, 0), b3, voffB);
            PG8_BAR; PG8_WAIT_L(0); PG8_MMA(0, 1, At, B1); PG8_BAR;
            PG8_LDA(At, 1, 1); PG8_STAGE(PG8_SA(1, 0), a3, voffA);
            PG8_BAR; PG8_WAIT_L(0); PG8_MMA(1, 0, At, B0); PG8_BAR; PG8_SCHED;
            PG8_STAGE(PG8_SB(1, 1), b3 + hstep, voffB);
            PG8_WAIT_V(6); PG8_BAR; PG8_MMA(1, 1, At, B1); PG8_BAR;
        }
        E(acc, cur, wr, wc, fr, fq);
        if (!has_next) break;
        if (!E.keep(cur))
#pragma unroll
        for (int a = 0; a < 2; ++a)
#pragma unroll
            for (int b = 0; b < 2; ++b)
#pragma unroll
                for (int m = 0; m < 4; ++m)
#pragma unroll
                    for (int n = 0; n < 2; ++n) acc[a][b][m][n] = (f32x4){0.f, 0.f, 0.f, 0.f};
        cur = nxt; cA = nA; cB = nB; ++ui;
    }
    PG8_WAIT_V(0);
    if (wr == 0) PG8_BAR;
    PG8_BAR;
#undef PG8_SA
#undef PG8_SB
#undef PG8_STAGE
#undef PG8_LDA
#undef PG8_LDB
#undef PG8_MMA
#undef PG8_WAIT_V
#undef PG8_WAIT_L
#undef PG8_BAR
#undef PG8_SCHED
}
}
using pg8::Unit;
typedef f32x4 Acc[2][2][4][2];

DI u32x4 pack8(const f32x4& a, const f32x4& b) { u32x4 w; w.x = pk2(a[0], a[1]); w.y = pk2(a[2], a[3]); w.z = pk2(b[0], b[1]); w.w = pk2(b[2], b[3]); return w; }

struct Epi1 {
    DI bool keep(const Unit&) const { return false; }
    bf16_t *QS, *KK, *VI, *SG, *QB, *KB, *VB, *GA, *GB; float* LOGF; const float* lbl; const float* bgate;
    DI void operator()(const Acc& acc, const Unit& u, int wr, int wc, int fr, int fq) const {
        const int colt = u.pn * 256, sec = colt >> 10, row0 = u.pm * 256 + wr * 64 + fr, cw = wc * 32 + 8 * fq;
        if (sec == 1) {
#pragma unroll
            for (int bj = 0; bj < 2; ++bj) {
                const int c = colt - 1024 + bj * 128 + cw;
                const f32x4 l0a = *(const f32x4*)(lbl + c), l0b = *(const f32x4*)(lbl + c + 4), l1a = *(const f32x4*)(lbl + 1024 + c), l1b = *(const f32x4*)(lbl + 1024 + c + 4);
                float lb[8];
#pragma unroll
                for (int j = 0; j < 4; ++j) { lb[j] = sigm(l0a[j] - l1a[j]); lb[4 + j] = sigm(l0b[j] - l1b[j]); }
#pragma unroll
                for (int ai = 0; ai < 2; ++ai)
#pragma unroll
                    for (int m = 0; m < 4; ++m) {
                        const size_t o = (size_t)(row0 + ai * 128 + m * 16) * 1024 + c;
                        f32x4 lf[2];
#pragma unroll
                        for (int n = 0; n < 2; ++n)
#pragma unroll
                            for (int j = 0; j < 4; ++j) {
                                const float z = fmaxf(acc[ai][bj][m][n][j], -30.f), e = __expf(-z), sg = __builtin_amdgcn_rcpf(1.f + e), l = lb[4 * n + j];
                                lf[n][j] = __logf(l + (1.f - l) * sg);
                            }
                        *(u32x4*)((_Float16*)LOGF + o) = (u32x4){pkh2(lf[0][0], lf[0][1]), pkh2(lf[0][2], lf[0][3]), pkh2(lf[1][0], lf[1][1]), pkh2(lf[1][2], lf[1][3])};
                    }
            }
            return;
        }
        if (sec >= 7) {
            unsigned char* dst8 = (unsigned char*)(sec < 9 ? GA : GB); const int coff8 = colt - (sec < 9 ? 7168 : 9216);
#pragma unroll
            for (int bj = 0; bj < 2; ++bj) {
                const int bc = colt - 7168 + bj * 128 + cw; const f32x4 b0 = *(const f32x4*)(bgate + bc), b1 = *(const f32x4*)(bgate + bc + 4);
#pragma unroll
                for (int ai = 0; ai < 2; ++ai)
#pragma unroll
                    for (int m = 0; m < 4; ++m) {
                        unsigned q[8];
#pragma unroll
                        for (int j = 0; j < 4; ++j) { q[j] = (unsigned)(sigm(acc[ai][bj][m][0][j] + b0[j]) * 255.f + 0.5f); q[4 + j] = (unsigned)(sigm(acc[ai][bj][m][1][j] + b1[j]) * 255.f + 0.5f); }
                        u32x2 w; w.x = q[0] | (q[1] << 8) | (q[2] << 16) | (q[3] << 24); w.y = q[4] | (q[5] << 8) | (q[6] << 16) | (q[7] << 24);
                        *(u32x2*)(dst8 + (size_t)(row0 + ai * 128 + m * 16) * 2048 + coff8 + bj * 128 + cw) = w;
                    }
            }
            return;
        }
        bf16_t* dst; int ld = 1024, coff, mode = 0;
        if (sec == 0) { dst = QS; coff = colt; }
        else if (sec == 2) { dst = VI; coff = colt - 2048; }
        else if (sec == 3) { dst = SG; coff = colt - 3072; }
        else if (sec == 4) { dst = QB; coff = colt - 4096; }
        else if (sec == 5) { dst = KB; coff = colt - 5120; }
        else { dst = VB; coff = colt - 6144; }
#pragma unroll
        for (int bj = 0; bj < 2; ++bj) {
            const int c = coff + bj * 128 + cw;
            f32x4 b0 = (f32x4){0.f, 0.f, 0.f, 0.f}, b1 = b0;
            if (mode == 2) { const int bc = colt - 7168 + bj * 128 + cw; b0 = *(const f32x4*)(bgate + bc); b1 = *(const f32x4*)(bgate + bc + 4); }
#pragma unroll
            for (int ai = 0; ai < 2; ++ai)
#pragma unroll
                for (int m = 0; m < 4; ++m) {
                    f32x4 v0 = acc[ai][bj][m][0], v1 = acc[ai][bj][m][1];
                    if (mode == 1) {
#pragma unroll
                        for (int j = 0; j < 4; ++j) { v0[j] = silu(v0[j]); v1[j] = silu(v1[j]); }
                    } else if (mode == 2) {
#pragma unroll
                        for (int j = 0; j < 4; ++j) { v0[j] = sigm(v0[j] + b0[j]); v1[j] = sigm(v1[j] + b1[j]); }
                    }
                    *(u32x4*)(dst + (size_t)(row0 + ai * 128 + m * 16) * ld + c) = pack8(v0, v1);
                }
        }
    }
};
struct Epi3 {
    const unsigned char *GA, *GB; bf16_t* MERGED;
    DI bool keep(const Unit& u) const { return u.sub == 0; }
    DI void operator()(Acc& acc, const Unit& u, int wr, int wc, int fr, int fq) const {
        const int row0 = u.pm * 256 + wr * 64 + fr, c0 = u.pn * 256 + wc * 32 + 8 * fq;
#pragma unroll
        for (int ai = 0; ai < 2; ++ai) {
            u32x2 ga[4][2], gb[4][2];
#pragma unroll
            for (int m = 0; m < 4; ++m)
#pragma unroll
                for (int bj = 0; bj < 2; ++bj) {
                    const size_t o = (size_t)(row0 + ai * 128 + m * 16) * DM + c0 + bj * 128;
                    gb[m][bj] = *(const u32x2*)(GB + o);
                    if (u.sub == 0) ga[m][bj] = *(const u32x2*)(GA + o);
                }
#pragma unroll
            for (int m = 0; m < 4; ++m)
#pragma unroll
                for (int bj = 0; bj < 2; ++bj) {
                    const unsigned bw[2] = {gb[m][bj].x, gb[m][bj].y};
                    float fb[8];
#pragma unroll
                    for (int j = 0; j < 8; ++j) fb[j] = fmaxf((float)((bw[j >> 2] >> (8 * (j & 3))) & 0xffu), 0.5f);
                    if (u.sub == 0) {
                        const unsigned aw[2] = {ga[m][bj].x, ga[m][bj].y};
#pragma unroll
                        for (int j = 0; j < 8; ++j) acc[ai][bj][m][j >> 2][j & 3] *= (float)((aw[j >> 2] >> (8 * (j & 3))) & 0xffu) * __builtin_amdgcn_rcpf(fb[j]);
                    } else {
                        const size_t o = (size_t)(row0 + ai * 128 + m * 16) * DM + c0 + bj * 128;
                        f32x4 v0 = acc[ai][bj][m][0], v1 = acc[ai][bj][m][1];
#pragma unroll
                        for (int j = 0; j < 4; ++j) { v0[j] *= fb[j] * (1.f / 255.f); v1[j] *= fb[4 + j] * (1.f / 255.f); }
                        *(u32x4*)(MERGED + o) = pack8(v0, v1);
                    }
                }
        }
    }
};
struct Epi4 {
    DI bool keep(const Unit&) const { return false; }
    const float* x; float* out; bf16_t* X1B; float* rowss;
    DI void operator()(const Acc& acc, const Unit& u, int wr, int wc, int fr, int fq) const {
        const int row0 = u.pm * 256 + wr * 64 + fr, c0 = u.pn * 256 + wc * 32 + 8 * fq;
#pragma unroll
        for (int ai = 0; ai < 2; ++ai)
            {
                constexpr int mp = 0;
                f32x4 x0[4][2], x1[4][2];
#pragma unroll
                for (int mm = 0; mm < 4; ++mm)
#pragma unroll
                    for (int bj = 0; bj < 2; ++bj) {
                        const size_t o = (size_t)(row0 + ai * 128 + (2 * mp + mm) * 16) * DM + c0 + bj * 128;
                        x0[mm][bj] = *(const f32x4*)(x + o); x1[mm][bj] = *(const f32x4*)(x + o + 4);
                    }
#pragma unroll
                for (int mm = 0; mm < 4; ++mm) {
                    const int m = 2 * mp + mm, row = row0 + ai * 128 + m * 16; float ss = 0.f;
#pragma unroll
                    for (int bj = 0; bj < 2; ++bj) {
                        const size_t o = (size_t)row * DM + c0 + bj * 128;
                        const f32x4 v0 = acc[ai][bj][m][0] + x0[mm][bj], v1 = acc[ai][bj][m][1] + x1[mm][bj];
                        *(u32x4*)(X1B + o) = pack8(v0, v1);
                        ss += (v0[0] * v0[0] + v0[1] * v0[1]) + (v0[2] * v0[2] + v0[3] * v0[3]) + (v1[0] * v1[0] + v1[1] * v1[1]) + (v1[2] * v1[2] + v1[3] * v1[3]);
                    }
                    ss += __shfl_xor(ss, 16); ss += __shfl_xor(ss, 32);
                    if (fq == 0) atomicAdd(rowss + row, ss);
                }
            }
    }
};
struct Epi5 {
    DI bool keep(const Unit&) const { return false; }
    const float* rowss; bf16_t* ACT;
    DI void operator()(const Acc& acc, const Unit& u, int wr, int wc, int fr, int fq) const {
        const int row0 = u.pm * 256 + wr * 64 + fr, c0 = u.pn * 128 + wc * 32 + 8 * fq;
        float rsv[2][4];
#pragma unroll
        for (int ai = 0; ai < 2; ++ai)
#pragma unroll
            for (int m = 0; m < 4; ++m) rsv[ai][m] = rowss[row0 + ai * 128 + m * 16];
#pragma unroll
        for (int ai = 0; ai < 2; ++ai)
#pragma unroll
            for (int m = 0; m < 4; ++m) {
                const int row = row0 + ai * 128 + m * 16;
                const float rs = rsqrtf(rsv[ai][m] * (1.f / DM) + EPS);
                f32x4 a0, a1;
#pragma unroll
                for (int j = 0; j < 4; ++j) { a0[j] = silu(acc[ai][0][m][0][j] * rs) * (acc[ai][1][m][0][j] * rs); a1[j] = silu(acc[ai][0][m][1][j] * rs) * (acc[ai][1][m][1][j] * rs); }
                *(u32x4*)(ACT + (size_t)row * DFF + c0) = pack8(a0, a1);
            }
    }
};
struct EpiNull {
    DI bool keep(const Unit&) const { return false; } float* sink;
    DI void operator()(const Acc& acc, const Unit& u, int wr, int wc, int fr, int fq) const {
        float t = 0.f;
#pragma unroll
        for (int ai = 0; ai < 2; ++ai)
#pragma unroll
            for (int bj = 0; bj < 2; ++bj)
#pragma unroll
                for (int m = 0; m < 4; ++m)
#pragma unroll
                    for (int n = 0; n < 2; ++n) t += acc[ai][bj][m][n][0] + acc[ai][bj][m][n][1] + acc[ai][bj][m][n][2] + acc[ai][bj][m][n][3];
        if (t == 12345.678f) sink[0] = t;
    }
};
struct Epi6 {
    DI bool keep(const Unit&) const { return false; }
    const bf16_t* X1B; float* out;
    DI void operator()(const Acc& acc, const Unit& u, int wr, int wc, int fr, int fq) const {
        const int row0 = u.pm * 256 + wr * 64 + fr, c0 = u.pn * 256 + wc * 32 + 8 * fq;
#pragma unroll
        for (int ai = 0; ai < 2; ++ai) {
            u32x4 xb[4][2];
#pragma unroll
            for (int m = 0; m < 4; ++m)
#pragma unroll
                for (int bj = 0; bj < 2; ++bj) xb[m][bj] = *(const u32x4*)(X1B + (size_t)(row0 + ai * 128 + m * 16) * DM + c0 + bj * 128);
#pragma unroll
            for (int m = 0; m < 4; ++m)
#pragma unroll
                for (int bj = 0; bj < 2; ++bj) {
                    const size_t o = (size_t)(row0 + ai * 128 + m * 16) * DM + c0 + bj * 128; const u32x4 t = xb[m][bj];
                    f32x4 v0 = acc[ai][bj][m][0], v1 = acc[ai][bj][m][1];
                    v0[0] += bflo(t.x); v0[1] += bfhi(t.x); v0[2] += bflo(t.y); v0[3] += bfhi(t.y); v1[0] += bflo(t.z); v1[1] += bfhi(t.z); v1[2] += bflo(t.w); v1[3] += bfhi(t.w);
                    *(f32x4*)(out + o) = v0; *(f32x4*)(out + o + 4) = v1;
                }
        }
    }
};

DI void transpose_item(const float* W, int K, int N, bf16_t* WT, int dst_row0, const float* kscale, LAS float* scr, int k0, int n0, int lane) {
    float rr[32];
#pragma unroll
    for (int i = 0; i < 32; ++i) rr[i] = W[(size_t)(k0 + 2 * i + (lane >> 5)) * N + n0 + (lane & 31)];
#pragma unroll
    for (int i = 0; i < 32; ++i) scr[(2 * i + (lane >> 5)) * 33 + (lane & 31)] = rr[i];
    asm volatile("s_waitcnt lgkmcnt(0)" ::: "memory");
    const int c = lane & 7;
    float sc[8];
#pragma unroll
    for (int i = 0; i < 8; ++i) sc[i] = kscale ? kscale[k0 + 8 * c + i] : 1.f;
#pragma unroll
    for (int j = 0; j < 4; ++j) { const int n = (lane >> 3) + 8 * j; const LAS float* s = scr + (8 * c) * 33 + n;
        u32x4 o; o.x = pk2(s[0 * 33] * sc[0], s[1 * 33] * sc[1]); o.y = pk2(s[2 * 33] * sc[2], s[3 * 33] * sc[3]); o.z = pk2(s[4 * 33] * sc[4], s[5 * 33] * sc[5]); o.w = pk2(s[6 * 33] * sc[6], s[7 * 33] * sc[7]);
        *(u32x4*)(WT + (size_t)(dst_row0 + n) * K + k0 + 8 * c) = o; }
    asm volatile("s_waitcnt lgkmcnt(0)" ::: "memory");
}
constexpr int I_IN = (DM / 64) * (NIN / 32), I_PA = (DA / 64) * (DM / 32), I_O = (DM / 64) * (DM / 32), I_F1 = I_IN, I_F2 = (DFF / 64) * (DM / 32);
constexpr int NITEMS = I_IN + 2 * I_PA + I_O + I_F1 + I_F2;
DI void convert_items(LAS unsigned char* L, const Params& p, int lo, int hi, int gw, int NGW) {
    const int tid = threadIdx.x, lane = tid & 63, wave = __builtin_amdgcn_readfirstlane(tid >> 6);
    LAS float* scr = (LAS float*)(L + wave * 16384);
    unsigned char* ws = p.ws;
    for (int it = lo + gw; it < hi; it += NGW) {
        int r = it;
        if (r < I_IN) { const int nblk = NIN / 32, kb = r / nblk, nb = r % nblk; transpose_item(p.in[1], DM, NIN, (bf16_t*)(ws + WS_WIN), 32 * nb, nullptr, scr, 64 * kb, 32 * nb, lane); continue; } r -= I_IN;
        if (r < I_PA) { const int nblk = DM / 32, kb = r / nblk, nb = r % nblk; transpose_item(p.in[10], DA, DM, (bf16_t*)(ws + WS_WPA), 32 * nb, nullptr, scr, 64 * kb, 32 * nb, lane); continue; } r -= I_PA;
        if (r < I_PA) { const int nblk = DM / 32, kb = r / nblk, nb = r % nblk; transpose_item(p.in[11], DA, DM, (bf16_t*)(ws + WS_WPB), 32 * nb, nullptr, scr, 64 * kb, 32 * nb, lane); continue; } r -= I_PA;
        if (r < I_O) { const int nblk = DM / 32, kb = r / nblk, nb = r % nblk; transpose_item(p.in[12], DM, DM, (bf16_t*)(ws + WS_WO), 32 * nb, nullptr, scr, 64 * kb, 32 * nb, lane); continue; } r -= I_O;
        if (r < I_F1) { const int nblk = NIN / 32, kb = r / nblk, nb = r % nblk; const int n0 = 32 * nb;
            const int nn = n0 < DFF ? n0 : n0 - DFF; const int drow = 256 * (nn >> 7) + (n0 < DFF ? 0 : 128) + (nn & 127);
            transpose_item(p.in[13], DM, NIN, (bf16_t*)(ws + WS_WF1), drow, p.in[4], scr, 64 * kb, n0, lane); continue; } r -= I_F1;
        { const int nblk = DM / 32, kb = r / nblk, nb = r % nblk; transpose_item(p.in[14], DFF, DM, (bf16_t*)(ws + WS_WF2), 32 * nb, nullptr, scr, 64 * kb, 32 * nb, lane); }
    }
}
DI void p0_prologue(LAS unsigned char* L, const Params& p, int G, int items_hi) {
    const int tid = threadIdx.x, lane = tid & 63, wave = __builtin_amdgcn_readfirstlane(tid >> 6);
    const int gw = blockIdx.x * 8 + wave, NGW = G * 8;
    unsigned char* ws = p.ws;
    convert_items(L, p, 0, items_hi, gw, NGW);
    bf16_t* H = (bf16_t*)p.out; const float* x = p.in[0]; const float* gain = p.in[3];
    for (int m = gw; m < MTOK; m += NGW) {
        const f32x4* xr = (const f32x4*)(x + (size_t)m * DM) + lane;
        f32x4 v[8]; float s = 0.f;
#pragma unroll
        for (int j = 0; j < 8; ++j) { v[j] = xr[64 * j]; s += (v[j][0] * v[j][0] + v[j][1] * v[j][1]) + (v[j][2] * v[j][2] + v[j][3] * v[j][3]); }
#pragma unroll
        for (int o = 1; o < 64; o <<= 1) s += __shfl_xor(s, o);
        const float rstd = rsqrtf(s * (1.f / DM) + EPS);
        u32x2* o8 = (u32x2*)(H + (size_t)m * DM) + lane;
#pragma unroll
        for (int j = 0; j < 8; ++j) { const f32x4 g = *((const f32x4*)gain + lane + 64 * j); u32x2 w; w.x = pk2(v[j][0] * rstd * g[0], v[j][1] * rstd * g[1]); w.y = pk2(v[j][2] * rstd * g[2], v[j][3] * rstd * g[3]); o8[64 * j] = w; }
    }
    float* rowss = (float*)(ws + WS_CTL);
    for (int i = blockIdx.x * 512 + tid; i < MTOK; i += G * 512) rowss[i] = 0.f;
}

DI void lds_barrier() { asm volatile("s_waitcnt lgkmcnt(0)" ::: "memory"); __builtin_amdgcn_s_barrier(); asm volatile("" ::: "memory"); }
DI bf16x8 ldfrag(const LAS bf16_t* base, int stride, int row, int k) { return *(const LAS bf16x8*)(base + row * stride + k); }
struct LocRegs { unsigned lfh[8]; unsigned q[8], v[8]; };
DI void local_load(LocRegs& r, const Params& p, int it, int tid) {
    const int bh = it >> 5, j = it & 31, b = bh >> 3, h = bh & 7, cp = tid & 63, rg = tid >> 6;
    const size_t g = ((size_t)b * SEQ + 64 * j + 8 * rg) * 1024 + h * 128 + 2 * cp;
    const float* LOGF = (const float*)(p.ws + WS_LOGF); const bf16_t* QS = (const bf16_t*)(p.ws + WS_QS); const bf16_t* KKp = (const bf16_t*)(p.ws + WS_KK); const bf16_t* VI = (const bf16_t*)(p.ws + WS_VI);
#pragma unroll
    for (int i = 0; i < 8; ++i) { r.lfh[i] = *(const unsigned*)((const _Float16*)LOGF + g + (size_t)i * 1024); r.q[i] = *(const unsigned*)(QS + g + (size_t)i * 1024);
        r.v[i] = *(const unsigned*)(VI + g + (size_t)i * 1024); }
}
DI void hgrn_local(LAS unsigned char* L, const Params& p, int it, const LocRegs& r) {
    const int tid = threadIdx.x, lane = tid & 63, w = __builtin_amdgcn_readfirstlane(tid >> 6), fr = lane & 15, fq = lane >> 4;
    const int bh = it >> 5, j = it & 31, b = bh >> 3, h = bh & 7, cp = lane, rg = w;
    unsigned char* ws = p.ws;
    bf16_t* QEg = (bf16_t*)(ws + WS_QEG); float* EVg = (float*)(ws + WS_EV) + (size_t)it * 256;
    u32x2* OIg = (u32x2*)((unsigned char*)p.out + OUT_OI); u32x4* Ug = (u32x4*)((unsigned char*)p.out + OUT_U);
    LAS bf16_t* QE = (LAS bf16_t*)(L + 0); LAS bf16_t* KE = (LAS bf16_t*)(L + 17408); LAS bf16_t* KET = (LAS bf16_t*)(L + 34816); LAS bf16_t* VT = (LAS bf16_t*)(L + 53248);
    LAS bf16_t* PP = (LAS bf16_t*)(L + 71680); LAS float* TOT = (LAS float*)(L + 115712);
    const int tb = w >> 1, wh = w & 1;
    const size_t tok0 = (size_t)b * SEQ + 64 * j;
    float c0[8], c1[8]; float r0 = 0.f, r1 = 0.f;
    float l0[8], l1[8];
#pragma unroll
    for (int i = 0; i < 8; ++i) { const f16x2_t hv = __builtin_bit_cast(f16x2_t, r.lfh[i]); l0[i] = (float)hv[0]; l1[i] = (float)hv[1]; r0 += l0[i]; r1 += l1[i]; c0[i] = r0; c1[i] = r1; }
    *(LAS f32x2*)(TOT + rg * 128 + 2 * cp) = (f32x2){r0, r1};
    lds_barrier();
    f32x2 pre = (f32x2){0.f, 0.f}, post = pre, off = pre;
#pragma unroll
    for (int g = 0; g < 8; ++g) { const f32x2 t = *(const LAS f32x2*)(TOT + g * 128 + 2 * cp);
        if (g < 4) { pre += t; if (g >= rg) off -= t; } else { post += t; if (g < rg) off += t; } }
    float k0s[8], k1s[8];
#pragma unroll
    for (int i = 0; i < 8; ++i) {
        const float e0 = c0[i] + off[0], e1 = c1[i] + off[1];
        const float qe0 = silu(bflo(r.q[i])) * __expf(fminf(e0, 60.f)), qe1 = silu(bfhi(r.q[i])) * __expf(fminf(e1, 60.f));
        k0s[i] = (1.f - __expf(l0[i])) * __expf(fminf(-e0, 60.f)); k1s[i] = (1.f - __expf(l1[i])) * __expf(fminf(-e1, 60.f));
        *(LAS unsigned*)(QE + (8 * rg + i) * 136 + 2 * cp) = pk2(qe0, qe1); *(LAS unsigned*)(KE + (8 * rg + i) * 136 + 2 * cp) = pk2(k0s[i], k1s[i]);
    }
    *(LAS u32x4*)(KET + (2 * cp) * 72 + 8 * rg) = (u32x4){pk2(k0s[0], k0s[1]), pk2(k0s[2], k0s[3]), pk2(k0s[4], k0s[5]), pk2(k0s[6], k0s[7])};
    *(LAS u32x4*)(KET + (2 * cp + 1) * 72 + 8 * rg) = (u32x4){pk2(k1s[0], k1s[1]), pk2(k1s[2], k1s[3]), pk2(k1s[4], k1s[5]), pk2(k1s[6], k1s[7])};
    *(LAS u32x4*)(VT + (2 * cp) * 72 + 8 * rg) = (u32x4){(r.v[0] & 0xffffu) | (r.v[1] << 16), (r.v[2] & 0xffffu) | (r.v[3] << 16), (r.v[4] & 0xffffu) | (r.v[5] << 16), (r.v[6] & 0xffffu) | (r.v[7] << 16)};
    *(LAS u32x4*)(VT + (2 * cp + 1) * 72 + 8 * rg) = (u32x4){(r.v[0] >> 16) | (r.v[1] & 0xffff0000u), (r.v[2] >> 16) | (r.v[3] & 0xffff0000u), (r.v[4] >> 16) | (r.v[5] & 0xffff0000u), (r.v[6] >> 16) | (r.v[7] & 0xffff0000u)};
    if (rg == 0) { *(f32x2*)(EVg + 2 * cp) = (f32x2){__expf(pre[0]), __expf(pre[1])}; *(f32x2*)(EVg + 128 + 2 * cp) = (f32x2){__expf(post[0]), __expf(post[1])}; }
    lds_barrier();
    {
        const int row = tid >> 3, c8 = (tid & 7) * 16;
        const int ksb = c8 & ~31, q0 = (c8 & 31) >> 3;
        const LAS bf16_t* src = QE + row * 136 + ksb;
        const u32x2 l0 = *(const LAS u32x2*)(src + 4 * q0), h0 = *(const LAS u32x2*)(src + 16 + 4 * q0), l1 = *(const LAS u32x2*)(src + 4 * q0 + 4), h1 = *(const LAS u32x2*)(src + 16 + 4 * q0 + 4);
        bf16_t* g = QEg + (tok0 + row) * 1024 + h * 128 + c8; *(u32x4*)g = (u32x4){l0.x, l0.y, h0.x, h0.y}; *(u32x4*)(g + 8) = (u32x4){l1.x, l1.y, h1.x, h1.y};
    }
    {
        bf16x8 qf[4];
#pragma unroll
        for (int ks = 0; ks < 4; ++ks) qf[ks] = ldfrag(QE, 136, 16 * tb + fr, 32 * ks + 8 * fq);
#pragma unroll
        for (int sbi = 0; sbi < 2; ++sbi) {
            const int sb = 2 * wh + sbi; f32x4 a = (f32x4){0.f, 0.f, 0.f, 0.f};
            if (sb <= tb) {
#pragma unroll
                for (int ks = 0; ks < 4; ++ks) a = MFMA16(ldfrag(KE, 136, 16 * sb + fr, 32 * ks + 8 * fq), qf[ks], a);
                if (sb == tb) {
#pragma unroll
                    for (int jj = 0; jj < 4; ++jj) if (4 * fq + jj > fr) a[jj] = 0.f;
                }
            }
            u32x2 o; o.x = pk2(a[0], a[1]); o.y = pk2(a[2], a[3]); *(LAS u32x2*)(PP + (16 * tb + fr) * 72 + 16 * sb + 4 * fq) = o;
        }
    }
    lds_barrier();
    {
        bf16x8 pf[2];
#pragma unroll
        for (int ks = 0; ks < 2; ++ks) pf[ks] = ldfrag(PP, 72, 16 * tb + fr, 32 * ks + 8 * fq);
#pragma unroll
        for (int i = 0; i < 4; ++i) { const int vb = 4 * wh + i; f32x4 a = (f32x4){0.f, 0.f, 0.f, 0.f};
#pragma unroll
            for (int ks = 0; ks < 2; ++ks) a = MFMA16(ldfrag(VT, 72, 16 * vb + fr, 32 * ks + 8 * fq), pf[ks], a);
            u32x2 ob; ob.x = pk2(a[0], a[1]); ob.y = pk2(a[2], a[3]); OIg[((size_t)(it * 8 + w) * 4 + i) * 64 + lane] = ob; }
        bf16x8 kf[2][2];
#pragma unroll
        for (int kb = 0; kb < 2; ++kb)
#pragma unroll
            for (int ks = 0; ks < 2; ++ks) kf[kb][ks] = ldfrag(KET, 72, 32 * tb + 16 * kb + fr, 32 * ks + 8 * fq);
#pragma unroll
        for (int v4 = 0; v4 < 4; ++v4) { const int vb = 4 * wh + v4; f32x4 a0 = (f32x4){0.f, 0.f, 0.f, 0.f}, a1 = a0;
#pragma unroll
            for (int ks = 0; ks < 2; ++ks) { const bf16x8 vf = ldfrag(VT, 72, 16 * vb + fr, 32 * ks + 8 * fq); a0 = MFMA16(kf[0][ks], vf, a0); a1 = MFMA16(kf[1][ks], vf, a1); }
            Ug[((size_t)(it * 8 + w) * 4 + v4) * 64 + lane] = pack8(a0, a1); }
    }
    lds_barrier();
}

struct SStage { u32x4 U[4]; f32x4 er0, er1, el0, el1; };
DI void sscan_load(SStage& r, const Params& p, int it, int w, int lane) {
    const u32x4* Ug = (const u32x4*)((unsigned char*)p.out + OUT_U); const float* EVg = (const float*)(p.ws + WS_EV) + (size_t)it * 256; const int fq = lane >> 4, k0 = 32 * (w >> 1) + 4 * fq;
#pragma unroll
    for (int v4 = 0; v4 < 4; ++v4) r.U[v4] = Ug[((size_t)(it * 8 + w) * 4 + v4) * 64 + lane];
    r.er0 = *(const f32x4*)(EVg + k0); r.er1 = *(const f32x4*)(EVg + k0 + 16); r.el0 = *(const f32x4*)(EVg + 128 + k0); r.el1 = *(const f32x4*)(EVg + 128 + k0 + 16);
}
DI void sscan_step(f32x4 (&S)[4][2], const SStage& r, u32x4* SSC, int it, int w, int lane) {
#pragma unroll
    for (int v4 = 0; v4 < 4; ++v4) {
        S[v4][0] *= r.er0; S[v4][1] *= r.er1;
        SSC[((size_t)(it * 8 + w) * 4 + v4) * 64 + lane] = pack8(S[v4][0], S[v4][1]);
        const u32x4 u = r.U[v4];
        S[v4][0][0] = (S[v4][0][0] + bflo(u.x)) * r.el0[0]; S[v4][0][1] = (S[v4][0][1] + bfhi(u.x)) * r.el0[1]; S[v4][0][2] = (S[v4][0][2] + bflo(u.y)) * r.el0[2]; S[v4][0][3] = (S[v4][0][3] + bfhi(u.y)) * r.el0[3];
        S[v4][1][0] = (S[v4][1][0] + bflo(u.z)) * r.el1[0]; S[v4][1][1] = (S[v4][1][1] + bfhi(u.z)) * r.el1[1]; S[v4][1][2] = (S[v4][1][2] + bflo(u.w)) * r.el1[2]; S[v4][1][3] = (S[v4][1][3] + bfhi(u.w)) * r.el1[3];
    }
}
DI void hgrn_sscan(const Params& p, int bh) {
    const int tid = threadIdx.x, lane = tid & 63, w = __builtin_amdgcn_readfirstlane(tid >> 6);
    u32x4* SSC = (u32x4*)(p.ws + WS_SSC);
    f32x4 S[4][2];
#pragma unroll
    for (int i = 0; i < 4; ++i) { S[i][0] = (f32x4){0.f, 0.f, 0.f, 0.f}; S[i][1] = S[i][0]; }
    SStage r0, r1, r2, r3;
    const int it0 = bh * 32;
    sscan_load(r0, p, it0 + 0, w, lane); sscan_load(r1, p, it0 + 1, w, lane); sscan_load(r2, p, it0 + 2, w, lane); sscan_load(r3, p, it0 + 3, w, lane);
    for (int j = 0; j < 32; j += 4) {
        sscan_step(S, r0, SSC, it0 + j, w, lane);     if (j + 4 < 32) sscan_load(r0, p, it0 + j + 4, w, lane);
        sscan_step(S, r1, SSC, it0 + j + 1, w, lane); if (j + 5 < 32) sscan_load(r1, p, it0 + j + 5, w, lane);
        sscan_step(S, r2, SSC, it0 + j + 2, w, lane); if (j + 6 < 32) sscan_load(r2, p, it0 + j + 6, w, lane);
        sscan_step(S, r3, SSC, it0 + j + 3, w, lane); if (j + 7 < 32) sscan_load(r3, p, it0 + j + 7, w, lane);
    }
}
DI void hgrn_ointer(const Params& p, int bi) {
    const int tid = threadIdx.x, lane = tid & 63, w = __builtin_amdgcn_readfirstlane(tid >> 6), fr = lane & 15, fq = lane >> 4;
    const int it = 2 * bi + (w >> 2), tb = w & 3, bh = it >> 5, j = it & 31, b = bh >> 3, h = bh & 7;
    unsigned char* ws = p.ws;
    const bf16_t* QEg = (const bf16_t*)(ws + WS_QEG); const u32x4* SSC = (const u32x4*)(ws + WS_SSC); const bf16_t* SG = (const bf16_t*)(ws + WS_SG); bf16_t* YA = (bf16_t*)(ws + WS_YA);
    const u32x2* OIg = (const u32x2*)((unsigned char*)p.out + OUT_OI);
    const size_t rowo = ((size_t)b * SEQ + 64 * j + 16 * tb + fr) * 1024 + h * 128;
    bf16x8 qf[4];
#pragma unroll
    for (int ks = 0; ks < 4; ++ks) qf[ks] = *(const bf16x8*)(QEg + rowo + 32 * ks + 8 * fq);
    u32x2 sg[8];
#pragma unroll
    for (int vb = 0; vb < 8; ++vb) sg[vb] = *(const u32x2*)(SG + rowo + 16 * vb + 4 * fq);
    f32x4 o[8]; float ss = 0.f;
#pragma unroll
    for (int hf = 0; hf < 2; ++hf) {
        bf16x8 sf[4][4]; u32x2 oi[4];
#pragma unroll
        for (int v4 = 0; v4 < 4; ++v4) {
            oi[v4] = OIg[((size_t)(it * 8 + 2 * tb + hf) * 4 + v4) * 64 + lane];
#pragma unroll
            for (int ks = 0; ks < 4; ++ks) { const u32x4 t = SSC[((size_t)(it * 8 + 2 * ks + hf) * 4 + v4) * 64 + lane]; sf[v4][ks] = __builtin_bit_cast(bf16x8, t); }
        }
#pragma unroll
        for (int v4 = 0; v4 < 4; ++v4) { f32x4 a = (f32x4){bflo(oi[v4].x), bfhi(oi[v4].x), bflo(oi[v4].y), bfhi(oi[v4].y)};
#pragma unroll
            for (int ks = 0; ks < 4; ++ks) a = MFMA16(sf[v4][ks], qf[ks], a);
            o[4 * hf + v4] = a; ss += (a[0] * a[0] + a[1] * a[1]) + (a[2] * a[2] + a[3] * a[3]); }
    }
    ss += __shfl_xor(ss, 16); ss += __shfl_xor(ss, 32);
    const float rn = rsqrtf(ss * (1.f / 128.f) + EPS);
#pragma unroll
    for (int vb = 0; vb < 8; ++vb) {
        const f32x4 gn = *(const f32x4*)(p.in[6] + h * 128 + 16 * vb + 4 * fq); const u32x2 g = sg[vb];
        u32x2 y; y.x = pk2(o[vb][0] * rn * gn[0] * silu(bflo(g.x)), o[vb][1] * rn * gn[1] * silu(bfhi(g.x))); y.y = pk2(o[vb][2] * rn * gn[2] * silu(bflo(g.y)), o[vb][3] * rn * gn[3] * silu(bfhi(g.y)));
        *(u32x2*)(YA + rowo + 16 * vb + 4 * fq) = y;
    }
}

DI void norm_rows_to_lds(u32x4 r, const float* g8, float mul, LAS bf16_t* dst) {
    float v[8] = {bflo(r.x), bfhi(r.x), bflo(r.y), bfhi(r.y), bflo(r.z), bfhi(r.z), bflo(r.w), bfhi(r.w)};
    float s = 0.f;
#pragma unroll
    for (int i = 0; i < 8; ++i) s += v[i] * v[i];
    s += __shfl_xor(s, 1); s += __shfl_xor(s, 2); s += __shfl_xor(s, 4); s += __shfl_xor(s, 8);
    const float rs = rsqrtf(s * (1.f / 128.f) + EPS) * mul;
    u32x4 o; o.x = pk2(v[0] * rs * g8[0], v[1] * rs * g8[1]); o.y = pk2(v[2] * rs * g8[2], v[3] * rs * g8[3]); o.z = pk2(v[4] * rs * g8[4], v[5] * rs * g8[5]); o.w = pk2(v[6] * rs * g8[6], v[7] * rs * g8[7]);
    *(LAS u32x4*)dst = o;
}
DI void vt_to_lds(u32x4 r0, u32x4 r1, LAS bf16_t* VTb, int vg, int sp) {
    const unsigned a[4] = {r0.x, r0.y, r0.z, r0.w}, c[4] = {r1.x, r1.y, r1.z, r1.w};
#pragma unroll
    for (int i = 0; i < 4; ++i) {
        *(LAS unsigned*)(VTb + (8 * vg + 2 * i) * 72 + 2 * sp) = (a[i] & 0xffffu) | (c[i] << 16);
        *(LAS unsigned*)(VTb + (8 * vg + 2 * i + 1) * 72 + 2 * sp) = (a[i] >> 16) | (c[i] & 0xffff0000u);
    }
}
struct KvRegs { u32x4 k0, k1, v0, v1; };
DI void kv_load(KvRegs& r, const bf16_t* KBp, const bf16_t* VBp, size_t kt, int h, int srow, int spc, int sp, int vg) {
    r.k0 = *(const u32x4*)(KBp + (kt + srow) * 1024 + h * 128 + 8 * spc); r.k1 = *(const u32x4*)(KBp + (kt + srow + 32) * 1024 + h * 128 + 8 * spc);
    r.v0 = *(const u32x4*)(VBp + (kt + 2 * sp) * 1024 + h * 128 + 8 * vg); r.v1 = *(const u32x4*)(VBp + (kt + 2 * sp + 1) * 1024 + h * 128 + 8 * vg);
}
DI void kv_store(const KvRegs& r, LAS bf16_t* KLn, LAS bf16_t* VTn, const float* kg, int srow, int spc, int sp, int vg) {
    norm_rows_to_lds(r.k0, kg, 1.f, KLn + srow * 136 + 8 * spc); norm_rows_to_lds(r.k1, kg, 1.f, KLn + (srow + 32) * 136 + 8 * spc);
    vt_to_lds(r.v0, r.v1, VTn, vg, sp);
}
DI void attn_item(LAS unsigned char* L, const Params& p, int it) {
    const int tid = threadIdx.x, lane = tid & 63, w = __builtin_amdgcn_readfirstlane(tid >> 6), fr = lane & 15, fq = lane >> 4;
    const int mI = it >> 5, bh = it & 31, b = bh >> 3, h = bh & 7, n0 = 2 * mI, nq = n0 + (w >> 2);
    unsigned char* ws = p.ws;
    const bf16_t* QBp = (const bf16_t*)(ws + WS_QB); const bf16_t* KBp = (const bf16_t*)(ws + WS_KB); const bf16_t* VBp = (const bf16_t*)(ws + WS_VB); bf16_t* YB = (bf16_t*)(ws + WS_YB);
    LAS bf16_t* QL = (LAS bf16_t*)(L + 0);
    LAS bf16_t* KL0 = (LAS bf16_t*)(L + 34816);
    LAS bf16_t* VTL0 = (LAS bf16_t*)(L + 69632);
    LAS float* BIAS = (LAS float*)(L + 106496);
    const size_t tok0 = (size_t)b * SEQ + 64 * n0; const int c0 = n0 > 8 ? n0 - 8 : 0, nch = n0 + 2 - c0;
    const int srow = tid >> 4, spc = tid & 15, sp = tid & 31, vg = tid >> 5;
    if (tid < 191) BIAS[tid] = p.in[9][h * 191 + tid];
    float kg[8];
#pragma unroll
    for (int i = 0; i < 8; ++i) kg[i] = p.in[8][8 * spc + i];
    KvRegs RA, RB;
    {
        const size_t kt0 = (size_t)b * SEQ + 64 * c0;
        KvRegs R0; kv_load(R0, KBp, VBp, kt0, h, srow, spc, sp, vg);
        kv_load(RB, KBp, VBp, kt0 + 64, h, srow, spc, sp, vg);
        float qg[8];
#pragma unroll
        for (int i = 0; i < 8; ++i) qg[i] = p.in[7][8 * spc + i];
#pragma unroll
        for (int ps = 0; ps < 4; ++ps) { const int row = srow + 32 * ps;
            norm_rows_to_lds(*(const u32x4*)(QBp + (tok0 + row) * 1024 + h * 128 + 8 * spc), qg, 0.08838834764831845f, QL + row * 136 + 8 * spc); }
        kv_store(R0, KL0, VTL0, kg, srow, spc, sp, vg);
    }
    __syncthreads();
    bf16x8 qf[4];
#pragma unroll
    for (int ks = 0; ks < 4; ++ks) qf[ks] = ldfrag(QL, 136, 16 * w + fr, 32 * ks + 8 * fq);
    float mrow = -1e30f, lrow = 0.f;
    f32x4 O[8];
#pragma unroll
    for (int i = 0; i < 8; ++i) O[i] = (f32x4){0.f, 0.f, 0.f, 0.f};
    const int qpos = 64 * nq + 16 * (w & 3) + fr;
#define ATT_ITER(i_, LD, ST) do { const int i = (i_); const int c = c0 + i, buf = i & 1; \
        if (i + 2 < nch) kv_load(LD, KBp, VBp, (size_t)b * SEQ + 64 * (c + 2), h, srow, spc, sp, vg); \
        if (c <= nq && c + 8 >= nq) { \
            const LAS bf16_t* KLb = KL0 + buf * 8704; const LAS bf16_t* VTb = VTL0 + buf * 9216; \
            f32x4 s[4]; \
            _Pragma("unroll") for (int kb = 0; kb < 4; ++kb) { s[kb] = (f32x4){0.f, 0.f, 0.f, 0.f}; \
                _Pragma("unroll") for (int ks = 0; ks < 4; ++ks) s[kb] = MFMA16(ldfrag(KLb, 136, 16 * kb + fr, 32 * ks + 8 * fq), qf[ks], s[kb]); } \
            const int d0 = qpos - (64 * c + 4 * fq); float mx = -1e30f; \
            _Pragma("unroll") for (int kb = 0; kb < 4; ++kb) _Pragma("unroll") for (int jj = 0; jj < 4; ++jj) { int d = d0 - 16 * kb - jj; d = d > 127 ? 127 : d; s[kb][jj] += BIAS[d + 63]; mx = fmaxf(mx, s[kb][jj]); } \
            mx = fmaxf(mx, __shfl_xor(mx, 16)); mx = fmaxf(mx, __shfl_xor(mx, 32)); \
            const float mn = fmaxf(mrow, mx), alpha = __expf(mrow - mn); mrow = mn; float ps = 0.f; \
            _Pragma("unroll") for (int kb = 0; kb < 4; ++kb) _Pragma("unroll") for (int jj = 0; jj < 4; ++jj) { s[kb][jj] = __expf(s[kb][jj] - mn); ps += s[kb][jj]; } \
            lrow = lrow * alpha + ps; \
            const u32x4 pw0 = pack8(s[0], s[1]), pw1 = pack8(s[2], s[3]); const bf16x8 pf0 = __builtin_bit_cast(bf16x8, pw0), pf1 = __builtin_bit_cast(bf16x8, pw1); \
            _Pragma("unroll") for (int vb = 0; vb < 8; ++vb) { O[vb] *= alpha; const LAS bf16_t* vr = VTb + (16 * vb + fr) * 72 + 4 * fq; \
                const u32x2 a0 = *(const LAS u32x2*)(vr), a1 = *(const LAS u32x2*)(vr + 16), a2 = *(const LAS u32x2*)(vr + 32), a3 = *(const LAS u32x2*)(vr + 48); \
                const u32x4 v0 = (u32x4){a0.x, a0.y, a1.x, a1.y}, v1 = (u32x4){a2.x, a2.y, a3.x, a3.y}; \
                O[vb] = MFMA16(__builtin_bit_cast(bf16x8, v0), pf0, O[vb]); O[vb] = MFMA16(__builtin_bit_cast(bf16x8, v1), pf1, O[vb]); } \
        } \
        if (i + 1 < nch) kv_store(ST, KL0 + (buf ^ 1) * 8704, VTL0 + (buf ^ 1) * 9216, kg, srow, spc, sp, vg); \
        lds_barrier(); } while (0)
    for (int ii = 0; ii < nch; ii += 2) { ATT_ITER(ii, RA, RB); if (ii + 1 < nch) ATT_ITER(ii + 1, RB, RA); }
#undef ATT_ITER
    lrow += __shfl_xor(lrow, 16); lrow += __shfl_xor(lrow, 32);
    {
        const float inv = 1.f / lrow;
        const size_t o0 = (tok0 + 16 * w + fr) * 1024 + h * 128 + 4 * fq;
#pragma unroll
        for (int vb = 0; vb < 8; ++vb) { u32x2 y; y.x = pk2(O[vb][0] * inv, O[vb][1] * inv); y.y = pk2(O[vb][2] * inv, O[vb][3] * inv); *(u32x2*)(YB + o0 + 16 * vb) = y; }
    }
}

__global__ void __launch_bounds__(512, 2) fwd_kernel(Params p) {
    extern __shared__ __attribute__((aligned(16))) unsigned char lds_raw[];
    LAS unsigned char* L = (LAS unsigned char*)lds_raw;
    cg::grid_group grid = cg::this_grid();
    __shared__ __attribute__((aligned(16))) unsigned xb_st[4];
    if (threadIdx.x < 4) xb_st[threadIdx.x] = 0u;
    __syncthreads();
    const XcdBarrier xbar = xcd_barrier_post((unsigned*)(p.ws + WS_BAR), (volatile LAS unsigned*)xb_st);
    if (p.ph_hi > 64) grid.sync();
    const int G = gridDim.x, lo = p.ph_lo, hi = p.ph_hi;
    unsigned char* ws = p.ws;
#define IN(k) (lo <= (k) && (k) < hi)
#define GSYNC() xcd_barrier(xbar)
#define SEAM(k) do { if ((k) + 1 < hi) GSYNC(); } while (0)
#define NREP(k) ((PROBE_DUP == (k)) ? 2 : 1)
    const int p1rem = ((MTOK / 256) * (NIN / 256)) % G;
    const bool late_in_p1 = (p1rem != 0) && (2 * p1rem <= G) && IN(0) && IN(1);
    const bool late_in_p5 = late_in_p1 && IN(5);
    if (IN(0)) { for (int rep = 0; rep < NREP(0); ++rep) { p0_prologue(L, p, G, late_in_p1 ? I_IN : NITEMS); if (rep + 1 < NREP(0)) GSYNC(); } SEAM(0); }
    if (IN(1)) {
        pg8::SchedPlain S{(const char*)p.out, (const char*)(ws + WS_WIN), MTOK / 256, NIN / 256, DM, G, (int)blockIdx.x};
        Epi1 E{(bf16_t*)(ws + WS_QS), (bf16_t*)(ws + WS_KK), (bf16_t*)(ws + WS_VI), (bf16_t*)(ws + WS_SG), (bf16_t*)(ws + WS_QB), (bf16_t*)(ws + WS_KB), (bf16_t*)(ws + WS_VB),
               (bf16_t*)(ws + WS_GA), (bf16_t*)(ws + WS_GB), (float*)(ws + WS_LOGF), p.in[5], p.in[2]};
        for (int rep = 0; rep < NREP(1); ++rep) { pg8::gemm_phase(L, DM, S, E); if (rep + 1 < NREP(1)) GSYNC(); }
        if (late_in_p1 && (int)blockIdx.x >= p1rem) convert_items(L, p, I_IN, late_in_p5 ? NITEMS - I_F2 : NITEMS, ((int)blockIdx.x - p1rem) * 8 + (int)(threadIdx.x >> 6), (G - p1rem) * 8);
        SEAM(1);
    }
    if (IN(2)) {
        {
            LocRegs ra, rb; int it = blockIdx.x;
            if (it < 1024) local_load(ra, p, it, threadIdx.x);
            for (; it < 1024; it += G) { const bool more = it + G < 1024; if (more) local_load(rb, p, it + G, threadIdx.x); hgrn_local(L, p, it, ra); if (more) ra = rb; }
        }
        GSYNC();
        if ((int)blockIdx.x < 32) hgrn_sscan(p, blockIdx.x);
        for (;;) {
            if (threadIdx.x == 0) xb_st[2] = atomicAdd((unsigned*)(ws + WS_QCTR), 1u);
            __syncthreads(); const unsigned it = xb_st[2]; __syncthreads();
            if (it >= 512u) break;
            attn_item(L, p, 511 - (int)it);
        }
        GSYNC();
        for (int bi = blockIdx.x; bi < 512; bi += G) hgrn_ointer(p, bi);
        SEAM(2);
    }
    if (IN(3)) {
        pg8::SchedDual S{(const char*)(ws + WS_YA), (const char*)(ws + WS_WPA), (const char*)(ws + WS_YB), (const char*)(ws + WS_WPB), MTOK / 256, DM / 256, DA, G, (int)blockIdx.x};
        Epi3 E{(const unsigned char*)(ws + WS_GA), (const unsigned char*)(ws + WS_GB), (bf16_t*)(ws + WS_MERGED)};
        for (int rep = 0; rep < NREP(3); ++rep) { pg8::gemm_phase(L, DA, S, E); if (rep + 1 < NREP(3)) GSYNC(); } SEAM(3);
    }
    if (IN(4)) {
        pg8::SchedPlain S{(const char*)(ws + WS_MERGED), (const char*)(ws + WS_WO), MTOK / 256, DM / 256, DM, G, (int)blockIdx.x};
        Epi4 E{p.in[0], p.out, (bf16_t*)(ws + WS_X1B), (float*)(ws + WS_CTL)};
        pg8::gemm_phase(L, DM, S, E); SEAM(4);
    }
    if (IN(5)) {
        pg8::SchedPlain S{(const char*)(ws + WS_X1B), (const char*)(ws + WS_WF1), MTOK / 256, NIN / 256, DM, G, (int)blockIdx.x};
        Epi5 E{(const float*)(ws + WS_CTL), (bf16_t*)(ws + WS_ACT)};
        for (int rep = 0; rep < NREP(5); ++rep) { pg8::gemm_phase(L, DM, S, E); if (rep + 1 < NREP(5)) GSYNC(); }
        if (late_in_p5 && (int)blockIdx.x >= p1rem) convert_items(L, p, NITEMS - I_F2, NITEMS, ((int)blockIdx.x - p1rem) * 8 + (int)(threadIdx.x >> 6), (G - p1rem) * 8);
        SEAM(5);
    }
    if (IN(6)) {
        pg8::SchedPlain S{(const char*)(ws + WS_ACT), (const char*)(ws + WS_WF2), MTOK / 256, DM / 256, DFF, G, (int)blockIdx.x};
        Epi6 E{(const bf16_t*)(ws + WS_X1B), p.out};
        if (PROBE_DUP == 6) { EpiNull EN{(float*)(ws + WS_CTL) + 16000}; pg8::gemm_phase(L, DFF, S, EN); GSYNC(); }
        pg8::gemm_phase(L, DFF, S, E);
    }
#undef IN
#undef SEAM
}

extern "C" void kernel_launch(void* const* d_in, const int* in_sizes, int n_in, void* d_out, int out_size, void* d_ws, size_t ws_size, hipStream_t stream) {
    static int grid = 0;
    if (grid == 0) {
        if (n_in != 15 || out_size != MTOK * DM || ws_size < WS_END) { fprintf(stderr, "kernel_launch: unexpected shapes (n_in %d out %d ws %zu)\n", n_in, out_size, ws_size); grid = -1; return; }
        int dev = 0, cus = 0, per_cu = 0;
        hipGetDevice(&dev); hipDeviceGetAttribute(&cus, hipDeviceAttributeMultiprocessorCount, dev);
        if (hipFuncSetAttribute((const void*)fwd_kernel, hipFuncAttributeMaxDynamicSharedMemorySize, LDS_BYTES) != hipSuccess) { fprintf(stderr, "kernel_launch: hipFuncSetAttribute failed\n"); grid = -1; return; }
        if (hipOccupancyMaxActiveBlocksPerMultiprocessor(&per_cu, (const void*)fwd_kernel, 512, LDS_BYTES) != hipSuccess || per_cu < 1) { fprintf(stderr, "kernel_launch: occupancy query failed (%d)\n", per_cu); grid = -1; return; }
        grid = cus * per_cu;
    }
    if (grid < 0) return;
    if (hipMemsetAsync(d_ws, 0, 131072, stream) != hipSuccess) { fprintf(stderr, "kernel_launch: memset failed\n"); return; }
    Params p{};
    for (int i = 0; i < 15; ++i) p.in[i] = (const float*)d_in[i];
    p.out = (float*)d_out; p.ws = (unsigned char*)d_ws; p.ph_lo = 0; p.ph_hi = 7;
    void* args[] = {&p};
    hipError_t e = hipLaunchCooperativeKernel((const void*)fwd_kernel, dim3(grid), dim3(512), args, LDS_BYTES, stream);
    if (e != hipSuccess) fprintf(stderr, "cooperative launch failed: %s (grid %d)\n", hipGetErrorString(e), grid);
}
```

```cpp
#include <hip/hip_runtime.h>
#include <hip/hip_cooperative_groups.h>
#include <cstdio>
namespace cg = cooperative_groups;

#define LAS __attribute__((address_space(3)))
#define DI __device__ __forceinline__
typedef unsigned short bf16_t;
typedef short bf16x8 __attribute__((ext_vector_type(8)));
typedef float f32x4 __attribute__((ext_vector_type(4)));
typedef float f32x2 __attribute__((ext_vector_type(2)));
typedef unsigned u32x4 __attribute__((ext_vector_type(4)));
typedef unsigned u32x2 __attribute__((ext_vector_type(2)));
typedef __bf16 bf16x2_t __attribute__((ext_vector_type(2)));

constexpr int MTOK = 8192, DM = 2048, NIN = 11264, DFF = 5632, DA = 1024, SEQ = 2048;
constexpr float EPS = 1e-6f;
constexpr size_t MiB = 1u << 20;
constexpr size_t WS_CTL = 0;
constexpr size_t WS_WIN = 1 * MiB;
constexpr size_t WS_YA = 1 * MiB, WS_YB = 17 * MiB, WS_X1B = 1 * MiB;
constexpr size_t WS_WPA = 45 * MiB, WS_WPB = 49 * MiB, WS_WO = 53 * MiB, WS_WF1 = 61 * MiB, WS_WF2 = 105 * MiB;
constexpr size_t WS_QS = 127 * MiB, WS_KK = 143 * MiB, WS_VI = 159 * MiB, WS_SG = 175 * MiB, WS_LOGF = 191 * MiB;
constexpr size_t WS_QB = 223 * MiB, WS_KB = 239 * MiB, WS_VB = 255 * MiB, WS_GA = 271 * MiB, WS_GB = 303 * MiB, WS_QEG = 335 * MiB, WS_END = 351 * MiB;
constexpr size_t WS_EV = 33 * MiB;
constexpr size_t WS_SSC = 191 * MiB;
constexpr size_t WS_QCTR = 131072 - 256;
constexpr size_t OUT_OI = 0, OUT_U = 32 * MiB;
constexpr size_t WS_MERGED = 127 * MiB;
constexpr size_t WS_ACT = 159 * MiB;
constexpr int LDS_BYTES = 131072;
#ifndef PROBE_DUP
#define PROBE_DUP -1
#endif


struct Params { const float* in[15]; float* out; unsigned char* ws; int ph_lo, ph_hi; };

DI unsigned pk2(float lo, float hi) { f32x2 v = {lo, hi}; bf16x2_t b = __builtin_convertvector(v, bf16x2_t); return __builtin_bit_cast(unsigned, b); }
typedef _Float16 f16x2_t __attribute__((ext_vector_type(2)));
DI unsigned pkh2(float a, float b) { f16x2_t v = {(_Float16)a, (_Float16)b}; return __builtin_bit_cast(unsigned, v); }
DI float bflo(unsigned u) { return __uint_as_float(u << 16); }
DI float bfhi(unsigned u) { return __uint_as_float(u & 0xffff0000u); }
DI float bf2f(bf16_t b) { return __uint_as_float(((unsigned)b) << 16); }
DI float sigm(float x) { return __builtin_amdgcn_rcpf(1.f + __expf(-x)); }
DI float silu(float x) { return x * sigm(x); }
#define MFMA16(a, b, c) __builtin_amdgcn_mfma_f32_16x16x32_bf16((a), (b), (c), 0, 0, 0)


#define XB_TMO      128
#define XB_XCNT(j)  (256  + 64 * (j))
#define XB_XSUB(j)  (1280 + 64 * (j))
#define XB_XGEN(j)  (2304 + 64 * (j))
#define XB_TOP      3328
#define XB_TOPGEN   3392
#define XCD_BAR_WORDS 3456
#define XB_SPIN_CAP (1u << 18)
DI unsigned xb_ld(unsigned* p)              { return __hip_atomic_load(p, __ATOMIC_RELAXED, __HIP_MEMORY_SCOPE_AGENT); }
DI unsigned xb_add(unsigned* p, unsigned v) { return __hip_atomic_fetch_add(p, v, __ATOMIC_RELAXED, __HIP_MEMORY_SCOPE_AGENT); }
DI unsigned xb_xcc_id() { return (unsigned)__builtin_amdgcn_s_getreg((3 << 11) | 20) & 0xFu; }
#define XB_SPIN(cond, bar) do { unsigned _sp = 0; while (cond) { __builtin_amdgcn_s_sleep(1); \
    if ((++_sp & 255u) == 0u) { if (xb_ld(&(bar)[XB_TMO])) break; if (_sp > XB_SPIN_CAP) { atomicAdd(&(bar)[XB_TMO], 1u); break; } } } } while (0)
struct XcdBarrier { unsigned* bar; unsigned x; volatile LAS unsigned* st; };
DI XcdBarrier xcd_barrier_post(unsigned* bar, volatile LAS unsigned* st) {
    XcdBarrier b; b.bar = bar; b.x = xb_xcc_id(); b.st = st;
    if (threadIdx.x == 0) (void)xb_add(&bar[XB_XCNT(b.x)], 1u);
    return b;
}
DI void xcd_barrier_complete(unsigned* bar, unsigned x, unsigned& nloc, unsigned& nx) {
    const unsigned G = gridDim.x * gridDim.y * gridDim.z;
    unsigned sum, cnt, mine, sp = 0u;
    for (;;) {
        sum = 0u; cnt = 0u; mine = 0u;
#pragma unroll
        for (unsigned j = 0; j < 16; ++j) { const unsigned c = xb_ld(&bar[XB_XCNT(j)]); sum += c; cnt += (c > 0u) ? 1u : 0u; mine = (j == x) ? c : mine; }
        if (sum == G) break;
        __builtin_amdgcn_s_sleep(1);
        if ((++sp & 255u) == 0u) { if (xb_ld(&bar[XB_TMO])) break; if (sp > XB_SPIN_CAP) { atomicAdd(&bar[XB_TMO], 1u); break; } }
    }
    nloc = mine > 0u ? mine : 1u; nx = cnt > 0u ? cnt : 1u;
}
DI void xcd_barrier(const XcdBarrier& b) {
    asm volatile("s_waitcnt vmcnt(0)" ::: "memory");
    __syncthreads();
    if (threadIdx.x == 0) {
        unsigned* bar = b.bar;
        __builtin_amdgcn_s_waitcnt(0);
        unsigned nloc = b.st[0], nx = b.st[1];
        if (nloc == 0u) { xcd_barrier_complete(bar, b.x, nloc, nx); b.st[0] = nloc; b.st[1] = nx; }
        const unsigned old = xb_add(&bar[XB_XSUB(b.x)], 1u);
        const unsigned gen = old / nloc;
        if (old + 1u == (gen + 1u) * nloc) {
            __builtin_amdgcn_fence(__ATOMIC_RELEASE, "agent");
            asm volatile("s_waitcnt vmcnt(0)" ::: "memory");
            const unsigned og = xb_add(&bar[XB_TOP], 1u);
            const unsigned tg = og / nx;
            if (og + 1u == (tg + 1u) * nx) xb_add(&bar[XB_TOPGEN], 1u);
            else XB_SPIN(xb_ld(&bar[XB_TOPGEN]) == tg, bar);
            __builtin_amdgcn_fence(__ATOMIC_ACQUIRE, "agent");
            xb_add(&bar[XB_XGEN(b.x)], 1u);
            asm volatile("s_waitcnt vmcnt(0)" ::: "memory");
        } else {
            XB_SPIN(xb_ld(&bar[XB_XGEN(b.x)]) == gen, bar);
            __builtin_amdgcn_fence(__ATOMIC_ACQUIRE, "agent");
            asm volatile("s_waitcnt vmcnt(0)" ::: "memory");
        }
    }
    __syncthreads();
}
constexpr size_t WS_BAR = 65536;

namespace pg8 {
constexpr int BM = 256, BK = 64, HALF = 128, HTB = HALF * BK * 2, STAGE_BYTES = 8 * HTB;
DI int lds_byte(int r, int c) { const int st = (r >> 4) * 2 + (c >> 5), rr = r & 15, cc = c & 31, ob = rr * 64 + cc * 2; return st * 1024 + (ob ^ (((ob >> 9) & 1) << 5)); }
DI void stage_rc(int b, int& R, int& C) { const int st = b / 1024, sb = b % 1024, swz = sb ^ (((sb >> 9) & 1) << 5); R = (st >> 1) * 16 + swz / 64; C = (st & 1) * 32 + (swz % 64) / 2; }
DI int perm32(int rho) { const int n = rho >> 4, i = rho & 15; return 8 * (i >> 2) + 4 * n + (i & 3); }
struct Unit { const char* A; const char* B; int pm, pn, sub; };
DI void tile_of(int L, int nM, int nN, int& pm, int& pn) {
    const int nwg = nM * nN; int wgid = L;
    { const int q = nwg / 8, r = nwg % 8, xcd = wgid % 8, off = wgid / 8; wgid = (xcd < r ? xcd * (q + 1) : r * (q + 1) + (xcd - r) * q) + off; }
    const int WGM = nN > 8 ? 2 : 4;
    const int nig = WGM * nN, gid = wgid / nig, fm = gid * WGM, gsz = (nM - fm) < WGM ? (nM - fm) : WGM;
    pm = fm + ((wgid % nig) % gsz); pn = (wgid % nig) / gsz;
}
struct SchedPlain {
    const char* A; const char* Bt; int nM, nN, K, G, c;
    DI bool next(int i, Unit& u) const {
        const long L = (long)i * G + c; if (L >= (long)nM * nN) return false;
        tile_of((int)L, nM, nN, u.pm, u.pn); u.sub = 0;
        u.A = A + (size_t)u.pm * 256 * K * 2; u.B = Bt + (size_t)u.pn * 256 * K * 2; return true;
    }
};
struct SchedDual {
    const char *A0, *B0, *A1, *B1; int nM, nN, K, G, c;
    DI bool next(int i, Unit& u) const {
        const long L = (long)(i >> 1) * G + c; if (L >= (long)nM * nN) return false;
        tile_of((int)L, nM, nN, u.pm, u.pn); u.sub = i & 1;
        u.A = (u.sub ? A1 : A0) + (size_t)u.pm * 256 * K * 2; u.B = (u.sub ? B1 : B0) + (size_t)u.pn * 256 * K * 2; return true;
    }
};

template <class Epi, class Sched>
DI void gemm_phase(LAS unsigned char* lds, const int K, const Sched& S, const Epi& E) {
    const int tid = threadIdx.x, wid = __builtin_amdgcn_readfirstlane(tid >> 6), lane = tid & 63, wr = wid >> 2, wc = wid & 3, fr = lane & 15, fq = lane >> 4;
    const int nt = K / BK;
    unsigned voffA[2], voffB[2];
#pragma unroll
    for (int i = 0; i < 2; ++i) { int R, C; stage_rc(tid * 16 + i * 8192, R, C); const int Rb = (R & ~31) + perm32(R & 31);
        voffA[i] = (unsigned)(R * K + C) * 2u; voffB[i] = (unsigned)(Rb * K + C) * 2u; }
    const size_t kstep = (size_t)(BK * 2);
    const size_t hstep = (size_t)HALF * K * 2;
    const unsigned ldsw = (unsigned)wid * 1024u;
    const int aoff = lds_byte(wr * 64 + fr, fq * 8), boff = lds_byte(wc * 32 + fr, fq * 8);
#define PG8_SA(b, h) (((b) * 2 + (h)) * HTB)
#define PG8_SB(b, h) ((4 + (b) * 2 + (h)) * HTB)
#define PG8_STAGE(bufoff, gbase, voff) do { _Pragma("unroll") for (int _i = 0; _i < 2; ++_i) \
        __builtin_amdgcn_global_load_lds((const unsigned*)((const char*)(gbase) + (voff)[_i]), (LAS unsigned*)(lds + (bufoff) + ldsw + _i * 8192), 16, 0, 0); } while (0)
#define PG8_LDA(dst, b, h) do { _Pragma("unroll") for (int m = 0; m < 4; ++m) _Pragma("unroll") for (int k = 0; k < 2; ++k) dst[m][k] = *(const LAS bf16x8*)(lds + PG8_SA(b, h) + aoff + m * 2048 + k * 1024); } while (0)
#define PG8_LDB(dst, b, h) do { _Pragma("unroll") for (int n = 0; n < 2; ++n) _Pragma("unroll") for (int k = 0; k < 2; ++k) dst[n][k] = *(const LAS bf16x8*)(lds + PG8_SB(b, h) + boff + n * 2048 + k * 1024); } while (0)
#define PG8_MMA(ai, bj, At, Bt) do { __builtin_amdgcn_s_setprio(1); _Pragma("unroll") for (int m = 0; m < 4; ++m) _Pragma("unroll") for (int n = 0; n < 2; ++n) _Pragma("unroll") for (int k = 0; k < 2; ++k) \
        acc[ai][bj][m][n] = __builtin_amdgcn_mfma_f32_16x16x32_bf16(Bt[n][k], At[m][k], acc[ai][bj][m][n], 0, 0, 0); __builtin_amdgcn_s_setprio(0); } while (0)
#define PG8_WAIT_V(n) asm volatile("s_waitcnt vmcnt(" #n ")" ::: "memory")
#define PG8_WAIT_L(n) asm volatile("s_waitcnt lgkmcnt(" #n ")" ::: "memory")
#define PG8_BAR __builtin_amdgcn_s_barrier()
#define PG8_SCHED __builtin_amdgcn_sched_barrier(0)
    Unit cur, nxt; int ui = 0;
    if (!S.next(0, cur)) return;
    f32x4 acc[2][2][4][2];
#pragma unroll
    for (int a = 0; a < 2; ++a)
#pragma unroll
        for (int b = 0; b < 2; ++b)
#pragma unroll
            for (int m = 0; m < 4; ++m)
#pragma unroll
                for (int n = 0; n < 2; ++n) acc[a][b][m][n] = (f32x4){0.f, 0.f, 0.f, 0.f};
    bf16x8 At[4][2], B0[2][2], B1[2][2];
    const char* cA = cur.A; const char* cB = cur.B;
    PG8_STAGE(PG8_SB(0, 0), cB, voffB); PG8_STAGE(PG8_SA(0, 0), cA, voffA); PG8_STAGE(PG8_SB(0, 1), cB + hstep, voffB); PG8_STAGE(PG8_SA(0, 1), cA + hstep, voffA);
    if (wr == 1) PG8_BAR;
    PG8_WAIT_V(4); PG8_BAR;
    PG8_STAGE(PG8_SB(1, 0), cB + kstep, voffB); PG8_STAGE(PG8_SA(1, 0), cA + kstep, voffA); PG8_STAGE(PG8_SB(1, 1), cB + hstep + kstep, voffB);
    PG8_WAIT_V(6); PG8_BAR;
    for (;;) {
        const bool has_next = S.next(ui + 1, nxt);
        const char* nA = has_next ? nxt.A : cA; const char* nB = has_next ? nxt.B : cB;
        for (int t = 0; t < nt; t += 2) {
            const bool last = (t == nt - 2);
            const char* a1 = cA + (size_t)(t + 1) * kstep;
            const char* a2 = last ? nA : cA + (size_t)(t + 2) * kstep; const char* b2 = last ? nB : cB + (size_t)(t + 2) * kstep;
            const char* a3 = a2 + kstep; const char* b3 = b2 + kstep;
            PG8_LDB(B0, 0, 0); PG8_SCHED; PG8_LDA(At, 0, 0); PG8_STAGE(PG8_SA(1, 1), a1 + hstep, voffA);
            PG8_WAIT_L(8); PG8_BAR; PG8_WAIT_L(0); PG8_MMA(0, 0, At, B0); PG8_BAR; PG8_SCHED;
            PG8_LDB(B1, 0, 1); PG8_STAGE(PG8_SB(0, 0), b2, voffB);
            PG8_BAR; PG8_WAIT_L(0); PG8_MMA(0, 1, At, B1); PG8_BAR;
            PG8_LDA(At, 0, 1); PG8_STAGE(PG8_SA(0, 0), a2, voffA);
            PG8_BAR; PG8_WAIT_L(0); PG8_MMA(1, 0, At, B0); PG8_BAR; PG8_SCHED;
            PG8_STAGE(PG8_SB(0, 1), b2 + hstep, voffB);
            PG8_WAIT_V(6); PG8_BAR; PG8_MMA(1, 1, At, B1); PG8_BAR;
            PG8_LDB(B0, 1, 0); PG8_SCHED; PG8_LDA(At, 1, 0); PG8_STAGE(PG8_SA(0, 1), a2 + hstep, voffA);
            PG8_WAIT_L(8); PG8_BAR; PG8_WAIT_L(0); PG8_MMA(0, 0, At, B0); PG8_BAR; PG8_SCHED;
            PG8_LDB(B1, 1, 1); PG8_STAGE(PG8_SB(1, 0), b3, voffB);
            PG8_BAR; PG8_WAIT_L(0); PG8_MMA(0, 1, At, B1); PG8_BAR;
            PG8_LDA(At, 1, 1); PG8_STAGE(PG8_SA(1, 0), a3, voffA);
            PG8_BAR; PG8_WAIT_L(0); PG8_MMA(1, 0, At, B0); PG8_BAR; PG8_SCHED;
            PG8_STAGE(PG8_SB(1, 1), b3 + hstep, voffB);
            PG8_WAIT_V(6); PG8_BAR; PG8_MMA(1, 1, At, B1); PG8_BAR;
        }
        E(acc, cur, wr, wc, fr, fq);
        if (!has_next) break;
        if (!E.keep(cur))
#pragma unroll
        for (int a = 0; a < 2; ++a)
#pragma unroll
            for (int b = 0; b < 2; ++b)
#pragma unroll
                for (int m = 0; m < 4; ++m)
#pragma unroll
                    for (int n = 0; n < 2; ++n) acc[a][b][m][n] = (f32x4){0.f, 0.f, 0.f, 0.f};
        cur = nxt; cA = nA; cB = nB; ++ui;
    }
    PG8_WAIT_V(0);
    if (wr == 0) PG8_BAR;
    PG8_BAR;
#undef PG8_SA
#undef PG8_SB
#undef PG8_STAGE
#undef PG8_LDA
#undef PG8_LDB
#undef PG8_MMA
#undef PG8_WAIT_V
#undef PG8_WAIT_L
#undef PG8_BAR
#undef PG8_SCHED
}
}
using pg8::Unit;
typedef f32x4 Acc[2][2][4][2];

DI u32x4 pack8(const f32x4& a, const f32x4& b) { u32x4 w; w.x = pk2(a[0], a[1]); w.y = pk2(a[2], a[3]); w.z = pk2(b[0], b[1]); w.w = pk2(b[2], b[3]); return w; }

struct Epi1 {
    DI bool keep(const Unit&) const { return false; }
    bf16_t *QS, *KK, *VI, *SG, *QB, *KB, *VB, *GA, *GB; float* LOGF; const float* lbl; const float* bgate;
    DI void operator()(const Acc& acc, const Unit& u, int wr, int wc, int fr, int fq) const {
        const int colt = u.pn * 256, sec = colt >> 10, row0 = u.pm * 256 + wr * 64 + fr, cw = wc * 32 + 8 * fq;
        if (sec == 1) {
#pragma unroll
            for (int bj = 0; bj < 2; ++bj) {
                const int c = colt - 1024 + bj * 128 + cw;
                const f32x4 l0a = *(const f32x4*)(lbl + c), l0b = *(const f32x4*)(lbl + c + 4), l1a = *(const f32x4*)(lbl + 1024 + c), l1b = *(const f32x4*)(lbl + 1024 + c + 4);
                float lb[8];
#pragma unroll
                for (int j = 0; j < 4; ++j) { lb[j] = sigm(l0a[j] - l1a[j]); lb[4 + j] = sigm(l0b[j] - l1b[j]); }
#pragma unroll
                for (int ai = 0; ai < 2; ++ai)
#pragma unroll
                    for (int m = 0; m < 4; ++m) {
                        const size_t o = (size_t)(row0 + ai * 128 + m * 16) * 1024 + c;
                        f32x4 lf[2];
#pragma unroll
                        for (int n = 0; n < 2; ++n)
#pragma unroll
                            for (int j = 0; j < 4; ++j) {
                                const float z = fmaxf(acc[ai][bj][m][n][j], -30.f), e = __expf(-z), sg = __builtin_amdgcn_rcpf(1.f + e), l = lb[4 * n + j];
                                lf[n][j] = __logf(l + (1.f - l) * sg);
                            }
                        *(u32x4*)((_Float16*)LOGF + o) = (u32x4){pkh2(lf[0][0], lf[0][1]), pkh2(lf[0][2], lf[0][3]), pkh2(lf[1][0], lf[1][1]), pkh2(lf[1][2], lf[1][3])};
                    }
            }
            return;
        }
        if (sec >= 7) {
            unsigned char* dst8 = (unsigned char*)(sec < 9 ? GA : GB); const int coff8 = colt - (sec < 9 ? 7168 : 9216);
#pragma unroll
            for (int bj = 0; bj < 2; ++bj) {
                const int bc = colt - 7168 + bj * 128 + cw; const f32x4 b0 = *(const f32x4*)(bgate + bc), b1 = *(const f32x4*)(bgate + bc + 4);
#pragma unroll
                for (int ai = 0; ai < 2; ++ai)
#pragma unroll
                    for (int m = 0; m < 4; ++m) {
                        unsigned q[8];
#pragma unroll
                        for (int j = 0; j < 4; ++j) { q[j] = (unsigned)(sigm(acc[ai][bj][m][0][j] + b0[j]) * 255.f + 0.5f); q[4 + j] = (unsigned)(sigm(acc[ai][bj][m][1][j] + b1[j]) * 255.f + 0.5f); }
                        u32x2 w; w.x = q[0] | (q[1] << 8) | (q[2] << 16) | (q[3] << 24); w.y = q[4] | (q[5] << 8) | (q[6] << 16) | (q[7] << 24);
                        *(u32x2*)(dst8 + (size_t)(row0 + ai * 128 + m * 16) * 2048 + coff8 + bj * 128 + cw) = w;
                    }
            }
            return;
        }
        bf16_t* dst; int ld = 1024, coff, mode = 0;
        if (sec == 0) { dst = QS; coff = colt; }
        else if (sec == 2) { dst = VI; coff = colt - 2048; }
        else if (sec == 3) { dst = SG; coff = colt - 3072; }
        else if (sec == 4) { dst = QB; coff = colt - 4096; }
        else if (sec == 5) { dst = KB; coff = colt - 5120; }
        else { dst = VB; coff = colt - 6144; }
#pragma unroll
        for (int bj = 0; bj < 2; ++bj) {
            const int c = coff + bj * 128 + cw;
            f32x4 b0 = (f32x4){0.f, 0.f, 0.f, 0.f}, b1 = b0;
            if (mode == 2) { const int bc = colt - 7168 + bj * 128 + cw; b0 = *(const f32x4*)(bgate + bc); b1 = *(const f32x4*)(bgate + bc + 4); }
#pragma unroll
            for (int ai = 0; ai < 2; ++ai)
#pragma unroll
                for (int m = 0; m < 4; ++m) {
                    f32x4 v0 = acc[ai][bj][m][0], v1 = acc[ai][bj][m][1];
                    if (mode == 1) {
#pragma unroll
                        for (int j = 0; j < 4; ++j) { v0[j] = silu(v0[j]); v1[j] = silu(v1[j]); }
                    } else if (mode == 2) {
#pragma unroll
                        for (int j = 0; j < 4; ++j) { v0[j] = sigm(v0[j] + b0[j]); v1[j] = sigm(v1[j] + b1[j]); }
                    }
                    *(u32x4*)(dst + (size_t)(row0 + ai * 128 + m * 16) * ld + c) = pack8(v0, v1);
                }
        }
    }
};
struct Epi3 {
    const unsigned char *GA, *GB; bf16_t* MERGED;
    DI bool keep(const Unit& u) const { return u.sub == 0; }
    DI void operator()(Acc& acc, const Unit& u, int wr, int wc, int fr, int fq) const {
        const int row0 = u.pm * 256 + wr * 64 + fr, c0 = u.pn * 256 + wc * 32 + 8 * fq;
#pragma unroll
        for (int ai = 0; ai < 2; ++ai) {
            u32x2 ga[4][2], gb[4][2];
#pragma unroll
            for (int m = 0; m < 4; ++m)
#pragma unroll
                for (int bj = 0; bj < 2; ++bj) {
                    const size_t o = (size_t)(row0 + ai * 128 + m * 16) * DM + c0 + bj * 128;
                    gb[m][bj] = *(const u32x2*)(GB + o);
                    if (u.sub == 0) ga[m][bj] = *(const u32x2*)(GA + o);
                }
#pragma unroll
            for (int m = 0; m < 4; ++m)
#pragma unroll
                for (int bj = 0; bj < 2; ++bj) {
                    const unsigned bw[2] = {gb[m][bj].x, gb[m][bj].y};
                    float fb[8];
#pragma unroll
                    for (int j = 0; j < 8; ++j) fb[j] = fmaxf((float)((bw[j >> 2] >> (8 * (j & 3))) & 0xffu), 0.5f);
                    if (u.sub == 0) {
                        const unsigned aw[2] = {ga[m][bj].x, ga[m][bj].y};
#pragma unroll
                        for (int j = 0; j < 8; ++j) acc[ai][bj][m][j >> 2][j & 3] *= (float)((aw[j >> 2] >> (8 * (j & 3))) & 0xffu) * __builtin_amdgcn_rcpf(fb[j]);
                    } else {
                        const size_t o = (size_t)(row0 + ai * 128 + m * 16) * DM + c0 + bj * 128;
                        f32x4 v0 = acc[ai][bj][m][0], v1 = acc[ai][bj][m][1];
#pragma unroll
                        for (int j = 0; j < 4; ++j) { v0[j] *= fb[j] * (1.f / 255.f); v1[j] *= fb[4 + j] * (1.f / 255.f); }
                        *(u32x4*)(MERGED + o) = pack8(v0, v1);
                    }
                }
        }
    }
};
struct Epi4 {
    DI bool keep(const Unit&) const { return false; }
    const float* x; float* out; bf16_t* X1B; float* rowss;
    DI void operator()(const Acc& acc, const Unit& u, int wr, int wc, int fr, int fq) const {
        const int row0 = u.pm * 256 + wr * 64 + fr, c0 = u.pn * 256 + wc * 32 + 8 * fq;
#pragma unroll
        for (int ai = 0; ai < 2; ++ai)
            {
                constexpr int mp = 0;
                f32x4 x0[4][2], x1[4][2];
#pragma unroll
                for (int mm = 0; mm < 4; ++mm)
#pragma unroll
                    for (int bj = 0; bj < 2; ++bj) {
                        const size_t o = (size_t)(row0 + ai * 128 + (2 * mp + mm) * 16) * DM + c0 + bj * 128;
                        x0[mm][bj] = *(const f32x4*)(x + o); x1[mm][bj] = *(const f32x4*)(x + o + 4);
                    }
#pragma unroll
                for (int mm = 0; mm < 4; ++mm) {
                    const int m = 2 * mp + mm, row = row0 + ai * 128 + m * 16; float ss = 0.f;
#pragma unroll
                    for (int bj = 0; bj < 2; ++bj) {
                        const size_t o = (size_t)row * DM + c0 + bj * 128;
                        const f32x4 v0 = acc[ai][bj][m][0] + x0[mm][bj], v1 = acc[ai][bj][m][1] + x1[mm][bj];
                        *(u32x4*)(X1B + o) = pack8(v0, v1);
                        ss += (v0[0] * v0[0] + v0[1] * v0[1]) + (v0[2] * v0[2] + v0[3] * v0[3]) + (v1[0] * v1[0] + v1[1] * v1[1]) + (v1[2] * v1[2] + v1[3] * v1[3]);
                    }
                    ss += __shfl_xor(ss, 16); ss += __shfl_xor(ss, 32);
                    if (fq == 0) atomicAdd(rowss + row, ss);
                }
            }
    }
};
struct Epi5 {
    DI bool keep(const Unit&) const { return false; }
    const float* rowss; bf16_t* ACT;
    DI void operator()(const Acc& acc, const Unit& u, int wr, int wc, int fr, int fq) const {
        const int row0 = u.pm * 256 + wr * 64 + fr, c0 = u.pn * 128 + wc * 32 + 8 * fq;
        float rsv[2][4];
#pragma unroll
        for (int ai = 0; ai < 2; ++ai)
#pragma unroll
            for (int m = 0; m < 4; ++m) rsv[ai][m] = rowss[row0 + ai * 128 + m * 16];
#pragma unroll
        for (int ai = 0; ai < 2; ++ai)
#pragma unroll
            for (int m = 0; m < 4; ++m) {
                const int row = row0 + ai * 128 + m * 16;
                const float rs = rsqrtf(rsv[ai][m] * (1.f / DM) + EPS);
                f32x4 a0, a1;
#pragma unroll
                for (int j = 0; j < 4; ++j) { a0[j] = silu(acc[ai][0][m][0][j] * rs) * (acc[ai][1][m][0][j] * rs); a1[j] = silu(acc[ai][0][m][1][j] * rs) * (acc[ai][1][m][1][j] * rs); }
                *(u32x4*)(ACT + (size_t)row * DFF + c0) = pack8(a0, a1);
            }
    }
};
struct EpiNull {
    DI bool keep(const Unit&) const { return false; } float* sink;
    DI void operator()(const Acc& acc, const Unit& u, int wr, int wc, int fr, int fq) const {
        float t = 0.f;
#pragma unroll
        for (int ai = 0; ai < 2; ++ai)
#pragma unroll
            for (int bj = 0; bj < 2; ++bj)
#pragma unroll
                for (int m = 0; m < 4; ++m)
#pragma unroll
                    for (int n = 0; n < 2; ++n) t += acc[ai][bj][m][n][0] + acc[ai][bj][m][n][1] + acc[ai][bj][m][n][2] + acc[ai][bj][m][n][3];
        if (t == 12345.678f) sink[0] = t;
    }
};
struct Epi6 {
    DI bool keep(const Unit&) const { return false; }
    const bf16_t* X1B; float* out;
    DI void operator()(const Acc& acc, const Unit& u, int wr, int wc, int fr, int fq) const {
        const int row0 = u.pm * 256 + wr * 64 + fr, c0 = u.pn * 256 + wc * 32 + 8 * fq;
#pragma unroll
        for (int ai = 0; ai < 2; ++ai) {
            u32x4 xb[4][2];
#pragma unroll
            for (int m = 0; m < 4; ++m)
#pragma unroll
                for (int bj = 0; bj < 2; ++bj) xb[m][bj] = *(const u32x4*)(X1B + (size_t)(row0 + ai * 128 + m * 16) * DM + c0 + bj * 128);
#pragma unroll
            for (int m = 0; m < 4; ++m)
#pragma unroll
                for (int bj = 0; bj < 2; ++bj) {
                    const size_t o = (size_t)(row0 + ai * 128 + m * 16) * DM + c0 + bj * 128; const u32x4 t = xb[m][bj];
                    f32x4 v0 = acc[ai][bj][m][0], v1 = acc[ai][bj][m][1];
                    v0[0] += bflo(t.x); v0[1] += bfhi(t.x); v0[2] += bflo(t.y); v0[3] += bfhi(t.y); v1[0] += bflo(t.z); v1[1] += bfhi(t.z); v1[2] += bflo(t.w); v1[3] += bfhi(t.w);
                    *(f32x4*)(out + o) = v0; *(f32x4*)(out + o + 4) = v1;
                }
        }
    }
};

DI void transpose_item(const float* W, int K, int N, bf16_t* WT, int dst_row0, const float* kscale, LAS float* scr, int k0, int n0, int lane) {
    float rr[32];
#pragma unroll
    for (int i = 0; i < 32; ++i) rr[i] = W[(size_t)(k0 + 2 * i + (lane >> 5)) * N + n0 + (lane & 31)];
#pragma unroll
    for (int i = 0; i < 32; ++i) scr[(2 * i + (lane >> 5)) * 33 + (lane & 31)] = rr[i];
    asm volatile("s_waitcnt lgkmcnt(0)" ::: "memory");
    const int c = lane & 7;
    float sc[8];
#pragma unroll
    for (int i = 0; i < 8; ++i) sc[i] = kscale ? kscale[k0 + 8 * c + i] : 1.f;
#pragma unroll
    for (int j = 0; j < 4; ++j) { const int n = (lane >> 3) + 8 * j; const LAS float* s = scr + (8 * c) * 33 + n;
        u32x4 o; o.x = pk2(s[0 * 33] * sc[0], s[1 * 33] * sc[1]); o.y = pk2(s[2 * 33] * sc[2], s[3 * 33] * sc[3]); o.z = pk2(s[4 * 33] * sc[4], s[5 * 33] * sc[5]); o.w = pk2(s[6 * 33] * sc[6], s[7 * 33] * sc[7]);
        *(u32x4*)(WT + (size_t)(dst_row0 + n) * K + k0 + 8 * c) = o; }
    asm volatile("s_waitcnt lgkmcnt(0)" ::: "memory");
}
constexpr int I_IN = (DM / 64) * (NIN / 32), I_PA = (DA / 64) * (DM / 32), I_O = (DM / 64) * (DM / 32), I_F1 = I_IN, I_F2 = (DFF / 64) * (DM / 32);
constexpr int NITEMS = I_IN + 2 * I_PA + I_O + I_F1 + I_F2;
DI void convert_items(LAS unsigned char* L, const Params& p, int lo, int hi, int gw, int NGW) {
    const int tid = threadIdx.x, lane = tid & 63, wave = __builtin_amdgcn_readfirstlane(tid >> 6);
    LAS float* scr = (LAS float*)(L + wave * 16384);
    unsigned char* ws = p.ws;
    for (int it = lo + gw; it < hi; it += NGW) {
        int r = it;
        if (r < I_IN) { const int nblk = NIN / 32, kb = r / nblk, nb = r % nblk; transpose_item(p.in[1], DM, NIN, (bf16_t*)(ws + WS_WIN), 32 * nb, nullptr, scr, 64 * kb, 32 * nb, lane); continue; } r -= I_IN;
        if (r < I_PA) { const int nblk = DM / 32, kb = r / nblk, nb = r % nblk; transpose_item(p.in[10], DA, DM, (bf16_t*)(ws + WS_WPA), 32 * nb, nullptr, scr, 64 * kb, 32 * nb, lane); continue; } r -= I_PA;
        if (r < I_PA) { const int nblk = DM / 32, kb = r / nblk, nb = r % nblk; transpose_item(p.in[11], DA, DM, (bf16_t*)(ws + WS_WPB), 32 * nb, nullptr, scr, 64 * kb, 32 * nb, lane); continue; } r -= I_PA;
        if (r < I_O) { const int nblk = DM / 32, kb = r / nblk, nb = r % nblk; transpose_item(p.in[12], DM, DM, (bf16_t*)(ws + WS_WO), 32 * nb, nullptr, scr, 64 * kb, 32 * nb, lane); continue; } r -= I_O;
        if (r < I_F1) { const int nblk = NIN / 32, kb = r / nblk, nb = r % nblk; const int n0 = 32 * nb;
            const int nn = n0 < DFF ? n0 : n0 - DFF; const int drow = 256 * (nn >> 7) + (n0 < DFF ? 0 : 128) + (nn & 127);
            transpose_item(p.in[13], DM, NIN, (bf16_t*)(ws + WS_WF1), drow, p.in[4], scr, 64 * kb, n0, lane); continue; } r -= I_F1;
        { const int nblk = DM / 32, kb = r / nblk, nb = r % nblk; transpose_item(p.in[14], DFF, DM, (bf16_t*)(ws + WS_WF2), 32 * nb, nullptr, scr, 64 * kb, 32 * nb, lane); }
    }
}
DI void p0_prologue(LAS unsigned char* L, const Params& p, int G, int items_hi) {
    const int tid = threadIdx.x, lane = tid & 63, wave = __builtin_amdgcn_readfirstlane(tid >> 6);
    const int gw = blockIdx.x * 8 + wave, NGW = G * 8;
    unsigned char* ws = p.ws;
    convert_items(L, p, 0, items_hi, gw, NGW);
    bf16_t* H = (bf16_t*)p.out; const float* x = p.in[0]; const float* gain = p.in[3];
    for (int m = gw; m < MTOK; m += NGW) {
        const f32x4* xr = (const f32x4*)(x + (size_t)m * DM) + lane;
        f32x4 v[8]; float s = 0.f;
#pragma unroll
        for (int j = 0; j < 8; ++j) { v[j] = xr[64 * j]; s += (v[j][0] * v[j][0] + v[j][1] * v[j][1]) + (v[j][2] * v[j][2] + v[j][3] * v[j][3]); }
#pragma unroll
        for (int o = 1; o < 64; o <<= 1) s += __shfl_xor(s, o);
        const float rstd = rsqrtf(s * (1.f / DM) + EPS);
        u32x2* o8 = (u32x2*)(H + (size_t)m * DM) + lane;
#pragma unroll
        for (int j = 0; j < 8; ++j) { const f32x4 g = *((const f32x4*)gain + lane + 64 * j); u32x2 w; w.x = pk2(v[j][0] * rstd * g[0], v[j][1] * rstd * g[1]); w.y = pk2(v[j][2] * rstd * g[2], v[j][3] * rstd * g[3]); o8[64 * j] = w; }
    }
    float* rowss = (float*)(ws + WS_CTL);
    for (int i = blockIdx.x * 512 + tid; i < MTOK; i += G * 512) rowss[i] = 0.f;
}

DI void lds_barrier() { asm volatile("s_waitcnt lgkmcnt(0)" ::: "memory"); __builtin_amdgcn_s_barrier(); asm volatile("" ::: "memory"); }
DI bf16x8 ldfrag(const LAS bf16_t* base, int stride, int row, int k) { return *(const LAS bf16x8*)(base + row * stride + k); }
struct LocRegs { unsigned lfh[8]; unsigned q[8], v[8]; };
DI void local_load(LocRegs& r, const Params& p, int it, int tid) {
    const int bh = it >> 5, j = it & 31, b = bh >> 3, h = bh & 7, cp = tid & 63, rg = tid >> 6;
    const size_t g = ((size_t)b * SEQ + 64 * j + 8 * rg) * 1024 + h * 128 + 2 * cp;
    const float* LOGF = (const float*)(p.ws + WS_LOGF); const bf16_t* QS = (const bf16_t*)(p.ws + WS_QS); const bf16_t* KKp = (const bf16_t*)(p.ws + WS_KK); const bf16_t* VI = (const bf16_t*)(p.ws + WS_VI);
#pragma unroll
    for (int i = 0; i < 8; ++i) { r.lfh[i] = *(const unsigned*)((const _Float16*)LOGF + g + (size_t)i * 1024); r.q[i] = *(const unsigned*)(QS + g + (size_t)i * 1024);
        r.v[i] = *(const unsigned*)(VI + g + (size_t)i * 1024); }
}
DI void hgrn_local(LAS unsigned char* L, const Params& p, int it, const LocRegs& r) {
    const int tid = threadIdx.x, lane = tid & 63, w = __builtin_amdgcn_readfirstlane(tid >> 6), fr = lane & 15, fq = lane >> 4;
    const int bh = it >> 5, j = it & 31, b = bh >> 3, h = bh & 7, cp = lane, rg = w;
    unsigned char* ws = p.ws;
    bf16_t* QEg = (bf16_t*)(ws + WS_QEG); float* EVg = (float*)(ws + WS_EV) + (size_t)it * 256;
    u32x2* OIg = (u32x2*)((unsigned char*)p.out + OUT_OI); u32x4* Ug = (u32x4*)((unsigned char*)p.out + OUT_U);
    LAS bf16_t* QE = (LAS bf16_t*)(L + 0); LAS bf16_t* KE = (LAS bf16_t*)(L + 17408); LAS bf16_t* KET = (LAS bf16_t*)(L + 34816); LAS bf16_t* VT = (LAS bf16_t*)(L + 53248);
    LAS bf16_t* PP = (LAS bf16_t*)(L + 71680); LAS float* TOT = (LAS float*)(L + 115712);
    const int tb = w >> 1, wh = w & 1;
    const size_t tok0 = (size_t)b * SEQ + 64 * j;
    float c0[8], c1[8]; float r0 = 0.f, r1 = 0.f;
    float l0[8], l1[8];
#pragma unroll
    for (int i = 0; i < 8; ++i) { const f16x2_t hv = __builtin_bit_cast(f16x2_t, r.lfh[i]); l0[i] = (float)hv[0]; l1[i] = (float)hv[1]; r0 += l0[i]; r1 += l1[i]; c0[i] = r0; c1[i] = r1; }
    *(LAS f32x2*)(TOT + rg * 128 + 2 * cp) = (f32x2){r0, r1};
    lds_barrier();
    f32x2 pre = (f32x2){0.f, 0.f}, post = pre, off = pre;
#pragma unroll
    for (int g = 0; g < 8; ++g) { const f32x2 t = *(const LAS f32x2*)(TOT + g * 128 + 2 * cp);
        if (g < 4) { pre += t; if (g >= rg) off -= t; } else { post += t; if (g < rg) off += t; } }
    float k0s[8], k1s[8];
#pragma unroll
    for (int i = 0; i < 8; ++i) {
        const float e0 = c0[i] + off[0], e1 = c1[i] + off[1];
        const float qe0 = silu(bflo(r.q[i])) * __expf(fminf(e0, 60.f)), qe1 = silu(bfhi(r.q[i])) * __expf(fminf(e1, 60.f));
        k0s[i] = (1.f - __expf(l0[i])) * __expf(fminf(-e0, 60.f)); k1s[i] = (1.f - __expf(l1[i])) * __expf(fminf(-e1, 60.f));
        *(LAS unsigned*)(QE + (8 * rg + i) * 136 + 2 * cp) = pk2(qe0, qe1); *(LAS unsigned*)(KE + (8 * rg + i) * 136 + 2 * cp) = pk2(k0s[i], k1s[i]);
    }
    *(LAS u32x4*)(KET + (2 * cp) * 72 + 8 * rg) = (u32x4){pk2(k0s[0], k0s[1]), pk2(k0s[2], k0s[3]), pk2(k0s[4], k0s[5]), pk2(k0s[6], k0s[7])};
    *(LAS u32x4*)(KET + (2 * cp + 1) * 72 + 8 * rg) = (u32x4){pk2(k1s[0], k1s[1]), pk2(k1s[2], k1s[3]), pk2(k1s[4], k1s[5]), pk2(k1s[6], k1s[7])};
    *(LAS u32x4*)(VT + (2 * cp) * 72 + 8 * rg) = (u32x4){(r.v[0] & 0xffffu) | (r.v[1] << 16), (r.v[2] & 0xffffu) | (r.v[3] << 16), (r.v[4] & 0xffffu) | (r.v[5] << 16), (r.v[6] & 0xffffu) | (r.v[7] << 16)};
    *(LAS u32x4*)(VT + (2 * cp + 1) * 72 + 8 * rg) = (u32x4){(r.v[0] >> 16) | (r.v[1] & 0xffff0000u), (r.v[2] >> 16) | (r.v[3] & 0xffff0000u), (r.v[4] >> 16) | (r.v[5] & 0xffff0000u), (r.v[6] >> 16) | (r.v[7] & 0xffff0000u)};
    if (rg == 0) { *(f32x2*)(EVg + 2 * cp) = (f32x2){__expf(pre[0]), __expf(pre[1])}; *(f32x2*)(EVg + 128 + 2 * cp) = (f32x2){__expf(post[0]), __expf(post[1])}; }
    lds_barrier();
    {
        const int row = tid >> 3, c8 = (tid & 7) * 16;
        const int ksb = c8 & ~31, q0 = (c8 & 31) >> 3;
        const LAS bf16_t* src = QE + row * 136 + ksb;
        const u32x2 l0 = *(const LAS u32x2*)(src + 4 * q0), h0 = *(const LAS u32x2*)(src + 16 + 4 * q0), l1 = *(const LAS u32x2*)(src + 4 * q0 + 4), h1 = *(const LAS u32x2*)(src + 16 + 4 * q0 + 4);
        bf16_t* g = QEg + (tok0 + row) * 1024 + h * 128 + c8; *(u32x4*)g = (u32x4){l0.x, l0.y, h0.x, h0.y}; *(u32x4*)(g + 8) = (u32x4){l1.x, l1.y, h1.x, h1.y};
    }
    {
        bf16x8 qf[4];
#pragma unroll
        for (int ks = 0; ks < 4; ++ks) qf[ks] = ldfrag(QE, 136, 16 * tb + fr, 32 * ks + 8 * fq);
#pragma unroll
        for (int sbi = 0; sbi < 2; ++sbi) {
            const int sb = 2 * wh + sbi; f32x4 a = (f32x4){0.f, 0.f, 0.f, 0.f};
            if (sb <= tb) {
#pragma unroll
                for (int ks = 0; ks < 4; ++ks) a = MFMA16(ldfrag(KE, 136, 16 * sb + fr, 32 * ks + 8 * fq), qf[ks], a);
                if (sb == tb) {
#pragma unroll
                    for (int jj = 0; jj < 4; ++jj) if (4 * fq + jj > fr) a[jj] = 0.f;
                }
            }
            u32x2 o; o.x = pk2(a[0], a[1]); o.y = pk2(a[2], a[3]); *(LAS u32x2*)(PP + (16 * tb + fr) * 72 + 16 * sb + 4 * fq) = o;
        }
    }
    lds_barrier();
    {
        bf16x8 pf[2];
#pragma unroll
        for (int ks = 0; ks < 2; ++ks) pf[ks] = ldfrag(PP, 72, 16 * tb + fr, 32 * ks + 8 * fq);
#pragma unroll
        for (int i = 0; i < 4; ++i) { const int vb = 4 * wh + i; f32x4 a = (f32x4){0.f, 0.f, 0.f, 0.f};
#pragma unroll
            for (int ks = 0; ks < 2; ++ks) a = MFMA16(ldfrag(VT, 72, 16 * vb + fr, 32 * ks + 8 * fq), pf[ks], a);
            u32x2 ob; ob.x = pk2(a[0], a[1]); ob.y = pk2(a[2], a[3]); OIg[((size_t)(it * 8 + w) * 4 + i) * 64 + lane] = ob; }
        bf16x8 kf[2][2];
#pragma unroll
        for (int kb = 0; kb < 2; ++kb)
#pragma unroll
            for (int ks = 0; ks < 2; ++ks) kf[kb][ks] = ldfrag(KET, 72, 32 * tb + 16 * kb + fr, 32 * ks + 8 * fq);
#pragma unroll
        for (int v4 = 0; v4 < 4; ++v4) { const int vb = 4 * wh + v4; f32x4 a0 = (f32x4){0.f, 0.f, 0.f, 0.f}, a1 = a0;
#pragma unroll
            for (int ks = 0; ks < 2; ++ks) { const bf16x8 vf = ldfrag(VT, 72, 16 * vb + fr, 32 * ks + 8 * fq); a0 = MFMA16(kf[0][ks], vf, a0); a1 = MFMA16(kf[1][ks], vf, a1); }
            Ug[((size_t)(it * 8 + w) * 4 + v4) * 64 + lane] = pack8(a0, a1); }
    }
    lds_barrier();
}

struct SStage { u32x4 U[4]; f32x4 er0, er1, el0, el1; };
DI void sscan_load(SStage& r, const Params& p, int it, int w, int lane) {
    const u32x4* Ug = (const u32x4*)((unsigned char*)p.out + OUT_U); const float* EVg = (const float*)(p.ws + WS_EV) + (size_t)it * 256; const int fq = lane >> 4, k0 = 32 * (w >> 1) + 4 * fq;
#pragma unroll
    for (int v4 = 0; v4 < 4; ++v4) r.U[v4] = Ug[((size_t)(it * 8 + w) * 4 + v4) * 64 + lane];
    r.er0 = *(const f32x4*)(EVg + k0); r.er1 = *(const f32x4*)(EVg + k0 + 16); r.el0 = *(const f32x4*)(EVg + 128 + k0); r.el1 = *(const f32x4*)(EVg + 128 + k0 + 16);
}
DI void sscan_step(f32x4 (&S)[4][2], const SStage& r, u32x4* SSC, int it, int w, int lane) {
#pragma unroll
    for (int v4 = 0; v4 < 4; ++v4) {
        S[v4][0] *= r.er0; S[v4][1] *= r.er1;
        SSC[((size_t)(it * 8 + w) * 4 + v4) * 64 + lane] = pack8(S[v4][0], S[v4][1]);
        const u32x4 u = r.U[v4];
        S[v4][0][0] = (S[v4][0][0] + bflo(u.x)) * r.el0[0]; S[v4][0][1] = (S[v4][0][1] + bfhi(u.x)) * r.el0[1]; S[v4][0][2] = (S[v4][0][2] + bflo(u.y)) * r.el0[2]; S[v4][0][3] = (S[v4][0][3] + bfhi(u.y)) * r.el0[3];
        S[v4][1][0] = (S[v4][1][0] + bflo(u.z)) * r.el1[0]; S[v4][1][1] = (S[v4][1][1] + bfhi(u.z)) * r.el1[1]; S[v4][1][2] = (S[v4][1][2] + bflo(u.w)) * r.el1[2]; S[v4][1][3] = (S[v4][1][3] + bfhi(u.w)) * r.el1[3];
    }
}
DI void hgrn_sscan(const Params& p, int bh) {
    const int tid = threadIdx.x, lane = tid & 63, w = __builtin_amdgcn_readfirstlane(tid >> 6);
    u32x4* SSC = (u32x4*)(p.ws + WS_SSC);
    f32x4 S[4][2];
#pragma unroll
    for (int i = 0; i < 4; ++i) { S[i][0] = (f32x4){0.f, 0.f, 0.f, 0.f}; S[i][1] = S[i][0]; }
    SStage r0, r1, r2, r3;
    const int it0 = bh * 32;
    sscan_load(r0, p, it0 + 0, w, lane); sscan_load(r1, p, it0 + 1, w, lane); sscan_load(r2, p, it0 + 2, w, lane); sscan_load(r3, p, it0 + 3, w, lane);
    for (int j = 0; j < 32; j += 4) {
        sscan_step(S, r0, SSC, it0 + j, w, lane);     if (j + 4 < 32) sscan_load(r0, p, it0 + j + 4, w, lane);
        sscan_step(S, r1, SSC, it0 + j + 1, w, lane); if (j + 5 < 32) sscan_load(r1, p, it0 + j + 5, w, lane);
        sscan_step(S, r2, SSC, it0 + j + 2, w, lane); if (j + 6 < 32) sscan_load(r2, p, it0 + j + 6, w, lane);
        sscan_step(S, r3, SSC, it0 + j + 3, w, lane); if (j + 7 < 32) sscan_load(r3, p, it0 + j + 7, w, lane);
    }
}
DI void hgrn_ointer(const Params& p, int bi) {
    const int tid = threadIdx.x, lane = tid & 63, w = __builtin_amdgcn_readfirstlane(tid >> 6), fr = lane & 15, fq = lane >> 4;
    const int it = 2 * bi + (w >> 2), tb = w & 3, bh = it >> 5, j = it & 31, b = bh >> 3, h = bh & 7;
    unsigned char* ws = p.ws;
    const bf16_t* QEg = (const bf16_t*)(ws + WS_QEG); const u32x4* SSC = (const u32x4*)(ws + WS_SSC); const bf16_t* SG = (const bf16_t*)(ws + WS_SG); bf16_t* YA = (bf16_t*)(ws + WS_YA);
    const u32x2* OIg = (const u32x2*)((unsigned char*)p.out + OUT_OI);
    const size_t rowo = ((size_t)b * SEQ + 64 * j + 16 * tb + fr) * 1024 + h * 128;
    bf16x8 qf[4];
#pragma unroll
    for (int ks = 0; ks < 4; ++ks) qf[ks] = *(const bf16x8*)(QEg + rowo + 32 * ks + 8 * fq);
    u32x2 sg[8];
#pragma unroll
    for (int vb = 0; vb < 8; ++vb) sg[vb] = *(const u32x2*)(SG + rowo + 16 * vb + 4 * fq);
    f32x4 o[8]; float ss = 0.f;
#pragma unroll
    for (int hf = 0; hf < 2; ++hf) {
        bf16x8 sf[4][4]; u32x2 oi[4];
#pragma unroll
        for (int v4 = 0; v4 < 4; ++v4) {
            oi[v4] = OIg[((size_t)(it * 8 + 2 * tb + hf) * 4 + v4) * 64 + lane];
#pragma unroll
            for (int ks = 0; ks < 4; ++ks) { const u32x4 t = SSC[((size_t)(it * 8 + 2 * ks + hf) * 4 + v4) * 64 + lane]; sf[v4][ks] = __builtin_bit_cast(bf16x8, t); }
        }
#pragma unroll
        for (int v4 = 0; v4 < 4; ++v4) { f32x4 a = (f32x4){bflo(oi[v4].x), bfhi(oi[v4].x), bflo(oi[v4].y), bfhi(oi[v4].y)};
#pragma unroll
            for (int ks = 0; ks < 4; ++ks) a = MFMA16(sf[v4][ks], qf[ks], a);
            o[4 * hf + v4] = a; ss += (a[0] * a[0] + a[1] * a[1]) + (a[2] * a[2] + a[3] * a[3]); }
    }
    ss += __shfl_xor(ss, 16); ss += __shfl_xor(ss, 32);
    const float rn = rsqrtf(ss * (1.f / 128.f) + EPS);
#pragma unroll
    for (int vb = 0; vb < 8; ++vb) {
        const f32x4 gn = *(const f32x4*)(p.in[6] + h * 128 + 16 * vb + 4 * fq); const u32x2 g = sg[vb];
        u32x2 y; y.x = pk2(o[vb][0] * rn * gn[0] * silu(bflo(g.x)), o[vb][1] * rn * gn[1] * silu(bfhi(g.x))); y.y = pk2(o[vb][2] * rn * gn[2] * silu(bflo(g.y)), o[vb][3] * rn * gn[3] * silu(bfhi(g.y)));
        *(u32x2*)(YA + rowo + 16 * vb + 4 * fq) = y;
    }
}

DI void norm_rows_to_lds(u32x4 r, const float* g8, float mul, LAS bf16_t* dst) {
    float v[8] = {bflo(r.x), bfhi(r.x), bflo(r.y), bfhi(r.y), bflo(r.z), bfhi(r.z), bflo(r.w), bfhi(r.w)};
    float s = 0.f;
#pragma unroll
    for (int i = 0; i < 8; ++i) s += v[i] * v[i];
    s += __shfl_xor(s, 1); s += __shfl_xor(s, 2); s += __shfl_xor(s, 4); s += __shfl_xor(s, 8);
    const float rs = rsqrtf(s * (1.f / 128.f) + EPS) * mul;
    u32x4 o; o.x = pk2(v[0] * rs * g8[0], v[1] * rs * g8[1]); o.y = pk2(v[2] * rs * g8[2], v[3] * rs * g8[3]); o.z = pk2(v[4] * rs * g8[4], v[5] * rs * g8[5]); o.w = pk2(v[6] * rs * g8[6], v[7] * rs * g8[7]);
    *(LAS u32x4*)dst = o;
}
DI void vt_to_lds(u32x4 r0, u32x4 r1, LAS bf16_t* VTb, int vg, int sp) {
    const unsigned a[4] = {r0.x, r0.y, r0.z, r0.w}, c[4] = {r1.x, r1.y, r1.z, r1.w};
#pragma unroll
    for (int i = 0; i < 4; ++i) {
        *(LAS unsigned*)(VTb + (8 * vg + 2 * i) * 72 + 2 * sp) = (a[i] & 0xffffu) | (c[i] << 16);
        *(LAS unsigned*)(VTb + (8 * vg + 2 * i + 1) * 72 + 2 * sp) = (a[i] >> 16) | (c[i] & 0xffff0000u);
    }
}
struct KvRegs { u32x4 k0, k1, v0, v1; };
DI void kv_load(KvRegs& r, const bf16_t* KBp, const bf16_t* VBp, size_t kt, int h, int srow, int spc, int sp, int vg) {
    r.k0 = *(const u32x4*)(KBp + (kt + srow) * 1024 + h * 128 + 8 * spc); r.k1 = *(const u32x4*)(KBp + (kt + srow + 32) * 1024 + h * 128 + 8 * spc);
    r.v0 = *(const u32x4*)(VBp + (kt + 2 * sp) * 1024 + h * 128 + 8 * vg); r.v1 = *(const u32x4*)(VBp + (kt + 2 * sp + 1) * 1024 + h * 128 + 8 * vg);
}
DI void kv_store(const KvRegs& r, LAS bf16_t* KLn, LAS bf16_t* VTn, const float* kg, int srow, int spc, int sp, int vg) {
    norm_rows_to_lds(r.k0, kg, 1.f, KLn + srow * 136 + 8 * spc); norm_rows_to_lds(r.k1, kg, 1.f, KLn + (srow + 32) * 136 + 8 * spc);
    vt_to_lds(r.v0, r.v1, VTn, vg, sp);
}
DI void attn_item(LAS unsigned char* L, const Params& p, int it) {
    const int tid = threadIdx.x, lane = tid & 63, w = __builtin_amdgcn_readfirstlane(tid >> 6), fr = lane & 15, fq = lane >> 4;
    const int mI = it >> 5, bh = it & 31, b = bh >> 3, h = bh & 7, n0 = 2 * mI, nq = n0 + (w >> 2);
    unsigned char* ws = p.ws;
    const bf16_t* QBp = (const bf16_t*)(ws + WS_QB); const bf16_t* KBp = (const bf16_t*)(ws + WS_KB); const bf16_t* VBp = (const bf16_t*)(ws + WS_VB); bf16_t* YB = (bf16_t*)(ws + WS_YB);
    LAS bf16_t* QL = (LAS bf16_t*)(L + 0);
    LAS bf16_t* KL0 = (LAS bf16_t*)(L + 34816);
    LAS bf16_t* VTL0 = (LAS bf16_t*)(L + 69632);
    LAS float* BIAS = (LAS float*)(L + 106496);
    const size_t tok0 = (size_t)b * SEQ + 64 * n0; const int c0 = n0 > 8 ? n0 - 8 : 0, nch = n0 + 2 - c0;
    const int srow = tid >> 4, spc = tid & 15, sp = tid & 31, vg = tid >> 5;
    if (tid < 191) BIAS[tid] = p.in[9][h * 191 + tid];
    float kg[8];
#pragma unroll
    for (int i = 0; i < 8; ++i) kg[i] = p.in[8][8 * spc + i];
    KvRegs RA, RB;
    {
        const size_t kt0 = (size_t)b * SEQ + 64 * c0;
        KvRegs R0; kv_load(R0, KBp, VBp, kt0, h, srow, spc, sp, vg);
        kv_load(RB, KBp, VBp, kt0 + 64, h, srow, spc, sp, vg);
        float qg[8];
#pragma unroll
        for (int i = 0; i < 8; ++i) qg[i] = p.in[7][8 * spc + i];
#pragma unroll
        for (int ps = 0; ps < 4; ++ps) { const int row = srow + 32 * ps;
            norm_rows_to_lds(*(const u32x4*)(QBp + (tok0 + row) * 1024 + h * 128 + 8 * spc), qg, 0.08838834764831845f, QL + row * 136 + 8 * spc); }
        kv_store(R0, KL0, VTL0, kg, srow, spc, sp, vg);
    }
    __syncthreads();
    bf16x8 qf[4];
#pragma unroll
    for (int ks = 0; ks < 4; ++ks) qf[ks] = ldfrag(QL, 136, 16 * w + fr, 32 * ks + 8 * fq);
    float mrow = -1e30f, lrow = 0.f;
    f32x4 O[8];
#pragma unroll
    for (int i = 0; i < 8; ++i) O[i] = (f32x4){0.f, 0.f, 0.f, 0.f};
    const int qpos = 64 * nq + 16 * (w & 3) + fr;
#define ATT_ITER(i_, LD, ST) do { const int i = (i_); const int c = c0 + i, buf = i & 1; \
        if (i + 2 < nch) kv_load(LD, KBp, VBp, (size_t)b * SEQ + 64 * (c + 2), h, srow, spc, sp, vg); \
        if (c <= nq && c + 8 >= nq) { \
            const LAS bf16_t* KLb = KL0 + buf * 8704; const LAS bf16_t* VTb = VTL0 + buf * 9216; \
            f32x4 s[4]; \
            _Pragma("unroll") for (int kb = 0; kb < 4; ++kb) { s[kb] = (f32x4){0.f, 0.f, 0.f, 0.f}; \
                _Pragma("unroll") for (int ks = 0; ks < 4; ++ks) s[kb] = MFMA16(ldfrag(KLb, 136, 16 * kb + fr, 32 * ks + 8 * fq), qf[ks], s[kb]); } \
            const int d0 = qpos - (64 * c + 4 * fq); float mx = -1e30f; \
            _Pragma("unroll") for (int kb = 0; kb < 4; ++kb) _Pragma("unroll") for (int jj = 0; jj < 4; ++jj) { int d = d0 - 16 * kb - jj; d = d > 127 ? 127 : d; s[kb][jj] += BIAS[d + 63]; mx = fmaxf(mx, s[kb][jj]); } \
            mx = fmaxf(mx, __shfl_xor(mx, 16)); mx = fmaxf(mx, __shfl_xor(mx, 32)); \
            const float mn = fmaxf(mrow, mx), alpha = __expf(mrow - mn); mrow = mn; float ps = 0.f; \
            _Pragma("unroll") for (int kb = 0; kb < 4; ++kb) _Pragma("unroll") for (int jj = 0; jj < 4; ++jj) { s[kb][jj] = __expf(s[kb][jj] - mn); ps += s[kb][jj]; } \
            lrow = lrow * alpha + ps; \
            const u32x4 pw0 = pack8(s[0], s[1]), pw1 = pack8(s[2], s[3]); const bf16x8 pf0 = __builtin_bit_cast(bf16x8, pw0), pf1 = __builtin_bit_cast(bf16x8, pw1); \
            _Pragma("unroll") for (int vb = 0; vb < 8; ++vb) { O[vb] *= alpha; const LAS bf16_t* vr = VTb + (16 * vb + fr) * 72 + 4 * fq; \
                const u32x2 a0 = *(const LAS u32x2*)(vr), a1 = *(const LAS u32x2*)(vr + 16), a2 = *(const LAS u32x2*)(vr + 32), a3 = *(const LAS u32x2*)(vr + 48); \
                const u32x4 v0 = (u32x4){a0.x, a0.y, a1.x, a1.y}, v1 = (u32x4){a2.x, a2.y, a3.x, a3.y}; \
                O[vb] = MFMA16(__builtin_bit_cast(bf16x8, v0), pf0, O[vb]); O[vb] = MFMA16(__builtin_bit_cast(bf16x8, v1), pf1, O[vb]); } \
        } \
        if (i + 1 < nch) kv_store(ST, KL0 + (buf ^ 1) * 8704, VTL0 + (buf ^ 1) * 9216, kg, srow, spc, sp, vg); \
        lds_barrier(); } while (0)
    for (int ii = 0; ii < nch; ii += 2) { ATT_ITER(ii, RA, RB); if (ii + 1 < nch) ATT_ITER(ii + 1, RB, RA); }
#undef ATT_ITER
    lrow += __shfl_xor(lrow, 16); lrow += __shfl_xor(lrow, 32);
    {
        const float inv = 1.f / lrow;
        const size_t o0 = (tok0 + 16 * w + fr) * 1024 + h * 128 + 4 * fq;
#pragma unroll
        for (int vb = 0; vb < 8; ++vb) { u32x2 y; y.x = pk2(O[vb][0] * inv, O[vb][1] * inv); y.y = pk2(O[vb][2] * inv, O[vb][3] * inv); *(u32x2*)(YB + o0 + 16 * vb) = y; }
    }
}

__global__ void __launch_bounds__(512, 2) fwd_kernel(Params p) {
    extern __shared__ __attribute__((aligned(16))) unsigned char lds_raw[];
    LAS unsigned char* L = (LAS unsigned char*)lds_raw;
    cg::grid_group grid = cg::this_grid();
    __shared__ __attribute__((aligned(16))) unsigned xb_st[4];
    if (threadIdx.x < 4) xb_st[threadIdx.x] = 0u;
    __syncthreads();
    const XcdBarrier xbar = xcd_barrier_post((unsigned*)(p.ws + WS_BAR), (volatile LAS unsigned*)xb_st);
    if (p.ph_hi > 64) grid.sync();
    const int G = gridDim.x, lo = p.ph_lo, hi = p.ph_hi;
    unsigned char* ws = p.ws;
#define IN(k) (lo <= (k) && (k) < hi)
#define GSYNC() xcd_barrier(xbar)
#define SEAM(k) do { if ((k) + 1 < hi) GSYNC(); } while (0)
#define NREP(k) ((PROBE_DUP == (k)) ? 2 : 1)
    const int p1rem = ((MTOK / 256) * (NIN / 256)) % G;
    const bool late_in_p1 = (p1rem != 0) && (2 * p1rem <= G) && IN(0) && IN(1);
    const bool late_in_p5 = late_in_p1 && IN(5);
    if (IN(0)) { for (int rep = 0; rep < NREP(0); ++rep) { p0_prologue(L, p, G, late_in_p1 ? I_IN : NITEMS); if (rep + 1 < NREP(0)) GSYNC(); } SEAM(0); }
    if (IN(1)) {
        pg8::SchedPlain S{(const char*)p.out, (const char*)(ws + WS_WIN), MTOK / 256, NIN / 256, DM, G, (int)blockIdx.x};
        Epi1 E{(bf16_t*)(ws + WS_QS), (bf16_t*)(ws + WS_KK), (bf16_t*)(ws + WS_VI), (bf16_t*)(ws + WS_SG), (bf16_t*)(ws + WS_QB), (bf16_t*)(ws + WS_KB), (bf16_t*)(ws + WS_VB),
               (bf16_t*)(ws + WS_GA), (bf16_t*)(ws + WS_GB), (float*)(ws + WS_LOGF), p.in[5], p.in[2]};
        for (int rep = 0; rep < NREP(1); ++rep) { pg8::gemm_phase(L, DM, S, E); if (rep + 1 < NREP(1)) GSYNC(); }
        if (late_in_p1 && (int)blockIdx.x >= p1rem) convert_items(L, p, I_IN, late_in_p5 ? NITEMS - I_F2 : NITEMS, ((int)blockIdx.x - p1rem) * 8 + (int)(threadIdx.x >> 6), (G - p1rem) * 8);
        SEAM(1);
    }
    if (IN(2)) {
        {
            LocRegs ra, rb; int it = blockIdx.x;
            if (it < 1024) local_load(ra, p, it, threadIdx.x);
            for (; it < 1024; it += G) { const bool more = it + G < 1024; if (more) local_load(rb, p, it + G, threadIdx.x); hgrn_local(L, p, it, ra); if (more) ra = rb; }
        }
        GSYNC();
        if ((int)blockIdx.x < 32) hgrn_sscan(p, blockIdx.x);
        for (;;) {
            if (threadIdx.x == 0) xb_st[2] = atomicAdd((unsigned*)(ws + WS_QCTR), 1u);
            __syncthreads(); const unsigned it = xb_st[2]; __syncthreads();
            if (it >= 512u) break;
            attn_item(L, p, 511 - (int)it);
        }
        GSYNC();
        for (int bi = blockIdx.x; bi < 512; bi += G) hgrn_ointer(p, bi);
        SEAM(2);
    }
    if (IN(3)) {
        pg8::SchedDual S{(const char*)(ws + WS_YA), (const char*)(ws + WS_WPA), (const char*)(ws + WS_YB), (const char*)(ws + WS_WPB), MTOK / 256, DM / 256, DA, G, (int)blockIdx.x};
        Epi3 E{(const unsigned char*)(ws + WS_GA), (const unsigned char*)(ws + WS_GB), (bf16_t*)(ws + WS_MERGED)};
        for (int rep = 0; rep < NREP(3); ++rep) { pg8::gemm_phase(L, DA, S, E); if (rep + 1 < NREP(3)) GSYNC(); } SEAM(3);
    }
    if (IN(4)) {
        pg8::SchedPlain S{(const char*)(ws + WS_MERGED), (const char*)(ws + WS_WO), MTOK / 256, DM / 256, DM, G, (int)blockIdx.x};
        Epi4 E{p.in[0], p.out, (bf16_t*)(ws + WS_X1B), (float*)(ws + WS_CTL)};
        pg8::gemm_phase(L, DM, S, E); SEAM(4);
    }
    if (IN(5)) {
        pg8::SchedPlain S{(const char*)(ws + WS_X1B), (const char*)(ws + WS_WF1), MTOK / 256, NIN / 256, DM, G, (int)blockIdx.x};
        Epi5 E{(const float*)(ws + WS_CTL), (bf16_t*)(ws + WS_ACT)};
        for (int rep = 0; rep < NREP(5); ++rep) { pg8::gemm_phase(L, DM, S, E); if (rep + 1 < NREP(5)) GSYNC(); }
        if (late_in_p5 && (int)blockIdx.x >= p1rem) convert_items(L, p, NITEMS - I_F2, NITEMS, ((int)blockIdx.x - p1rem) * 8 + (int)(threadIdx.x >> 6), (G - p1rem) * 8);
        SEAM(5);
    }
    if (IN(6)) {
        pg8::SchedPlain S{(const char*)(ws + WS_ACT), (const char*)(ws + WS_WF2), MTOK / 256, DM / 256, DFF, G, (int)blockIdx.x};
        Epi6 E{(const bf16_t*)(ws + WS_X1B), p.out};
        if (PROBE_DUP == 6) { EpiNull EN{(float*)(ws + WS_CTL) + 16000}; pg8::gemm_phase(L, DFF, S, EN); GSYNC(); }
        pg8::gemm_phase(L, DFF, S, E);
    }
#undef IN
#undef SEAM
}

extern "C" void kernel_launch(void* const* d_in, const int* in_sizes, int n_in, void* d_out, int out_size, void* d_ws, size_t ws_size, hipStream_t stream) {
    static int grid = 0;
    if (grid == 0) {
        if (n_in != 15 || out_size != MTOK * DM || ws_size < WS_END) { fprintf(stderr, "kernel_launch: unexpected shapes (n_in %d out %d ws %zu)\n", n_in, out_size, ws_size); grid = -1; return; }
        int dev = 0, cus = 0, per_cu = 0;
        hipGetDevice(&dev); hipDeviceGetAttribute(&cus, hipDeviceAttributeMultiprocessorCount, dev);
        if (hipFuncSetAttribute((const void*)fwd_kernel, hipFuncAttributeMaxDynamicSharedMemorySize, LDS_BYTES) != hipSuccess) { fprintf(stderr, "kernel_launch: hipFuncSetAttribute failed\n"); grid = -1; return; }
        if (hipOccupancyMaxActiveBlocksPerMultiprocessor(&per_cu, (const void*)fwd_kernel, 512, LDS_BYTES) != hipSuccess || per_cu < 1) { fprintf(stderr, "kernel_launch: occupancy query failed (%d)\n", per_cu); grid = -1; return; }
        grid = cus * per_cu;
    }
    if (grid < 0) return;
    if (hipMemsetAsync(d_ws, 0, 131072, stream) != hipSuccess) { fprintf(stderr, "kernel_launch: memset failed\n"); return; }
    Params p{};
    for (int i = 0; i < 15; ++i) p.in[i] = (const float*)d_in[i];
    p.out = (float*)d_out; p.ws = (unsigned char*)d_ws; p.ph_lo = 0; p.ph_hi = 7;
    void* args[] = {&p};
    hipError_t e = hipLaunchCooperativeKernel((const void*)fwd_kernel, dim3(grid), dim3(512), args, LDS_BYTES, stream);
    if (e != hipSuccess) fprintf(stderr, "cooperative launch failed: %s (grid %d)\n", hipGetErrorString(e), grid);
}
```

```cpp
#include <hip/hip_runtime.h>
#include <hip/hip_cooperative_groups.h>
#include <cstdio>
namespace cg = cooperative_groups;

#define LAS __attribute__((address_space(3)))
#define DI __device__ __forceinline__
typedef unsigned short bf16_t;
typedef short bf16x8 __attribute__((ext_vector_type(8)));
typedef float f32x4 __attribute__((ext_vector_type(4)));
typedef float f32x2 __attribute__((ext_vector_type(2)));
typedef unsigned u32x4 __attribute__((ext_vector_type(4)));
typedef unsigned u32x2 __attribute__((ext_vector_type(2)));
typedef __bf16 bf16x2_t __attribute__((ext_vector_type(2)));

constexpr int MTOK = 8192, DM = 2048, NIN = 11264, DFF = 5632, DA = 1024, SEQ = 2048;
constexpr float EPS = 1e-6f;
constexpr size_t MiB = 1u << 20;
constexpr size_t WS_CTL = 0;
constexpr size_t WS_WIN = 1 * MiB;
constexpr size_t WS_YA = 1 * MiB, WS_YB = 17 * MiB, WS_X1B = 1 * MiB;
constexpr size_t WS_WPA = 45 * MiB, WS_WPB = 49 * MiB, WS_WO = 53 * MiB, WS_WF1 = 61 * MiB, WS_WF2 = 105 * MiB;
constexpr size_t WS_QS = 127 * MiB, WS_KK = 143 * MiB, WS_VI = 159 * MiB, WS_SG = 175 * MiB, WS_LOGF = 191 * MiB;
constexpr size_t WS_QB = 223 * MiB, WS_KB = 239 * MiB, WS_VB = 255 * MiB, WS_GA = 271 * MiB, WS_GB = 303 * MiB, WS_QEG = 335 * MiB, WS_END = 351 * MiB;
constexpr size_t WS_EV = 33 * MiB;
constexpr size_t WS_SSC = 191 * MiB;
constexpr size_t WS_QCTR = 131072 - 256;
constexpr size_t OUT_OI = 0, OUT_U = 32 * MiB;
constexpr size_t WS_MERGED = 127 * MiB;
constexpr size_t WS_ACT = 159 * MiB;
constexpr int LDS_BYTES = 131072;
#define WGM_P1 2
#define WGM_P5 4
#ifndef PROBE_DUP
#define PROBE_DUP -1
#endif


struct Params { const float* in[15]; float* out; unsigned char* ws; int ph_lo, ph_hi; };

DI unsigned pk2(float lo, float hi) { f32x2 v = {lo, hi}; bf16x2_t b = __builtin_convertvector(v, bf16x2_t); return __builtin_bit_cast(unsigned, b); }
typedef _Float16 f16x2_t __attribute__((ext_vector_type(2)));
DI unsigned pkh2(float a, float b) { f16x2_t v = {(_Float16)a, (_Float16)b}; return __builtin_bit_cast(unsigned, v); }
DI float bflo(unsigned u) { return __uint_as_float(u << 16); }
DI float bfhi(unsigned u) { return __uint_as_float(u & 0xffff0000u); }
DI float bf2f(bf16_t b) { return __uint_as_float(((unsigned)b) << 16); }
DI float sigm(float x) { return __builtin_amdgcn_rcpf(1.f + __expf(-x)); }
DI float silu(float x) { return x * sigm(x); }
#define MFMA16(a, b, c) __builtin_amdgcn_mfma_f32_16x16x32_bf16((a), (b), (c), 0, 0, 0)


#define XB_TMO      128
#define XB_XCNT(j)  (256  + 64 * (j))
#define XB_XSUB(j)  (1280 + 64 * (j))
#define XB_XGEN(j)  (2304 + 64 * (j))
#define XB_TOP      3328
#define XB_TOPGEN   3392
#define XCD_BAR_WORDS 3456
#define XB_SPIN_CAP (1u << 18)
DI unsigned xb_ld(unsigned* p)              { return __hip_atomic_load(p, __ATOMIC_RELAXED, __HIP_MEMORY_SCOPE_AGENT); }
DI unsigned xb_add(unsigned* p, unsigned v) { return __hip_atomic_fetch_add(p, v, __ATOMIC_RELAXED, __HIP_MEMORY_SCOPE_AGENT); }
DI unsigned xb_xcc_id() { return (unsigned)__builtin_amdgcn_s_getreg((3 << 11) | 20) & 0xFu; }
#define XB_SPIN(cond, bar) do { unsigned _sp = 0; while (cond) { __builtin_amdgcn_s_sleep(1); \
    if ((++_sp & 255u) == 0u) { if (xb_ld(&(bar)[XB_TMO])) break; if (_sp > XB_SPIN_CAP) { atomicAdd(&(bar)[XB_TMO], 1u); break; } } } } while (0)
struct XcdBarrier { unsigned* bar; unsigned x; volatile LAS unsigned* st; };
DI XcdBarrier xcd_barrier_post(unsigned* bar, volatile LAS unsigned* st) {
    XcdBarrier b; b.bar = bar; b.x = xb_xcc_id(); b.st = st;
    if (threadIdx.x == 0) (void)xb_add(&bar[XB_XCNT(b.x)], 1u);
    return b;
}
DI void xcd_barrier_complete(unsigned* bar, unsigned x, unsigned& nloc, unsigned& nx) {
    const unsigned G = gridDim.x * gridDim.y * gridDim.z;
    unsigned sum, cnt, mine, sp = 0u;
    for (;;) {
        sum = 0u; cnt = 0u; mine = 0u;
#pragma unroll
        for (unsigned j = 0; j < 16; ++j) { const unsigned c = xb_ld(&bar[XB_XCNT(j)]); sum += c; cnt += (c > 0u) ? 1u : 0u; mine = (j == x) ? c : mine; }
        if (sum == G) break;
        __builtin_amdgcn_s_sleep(1);
        if ((++sp & 255u) == 0u) { if (xb_ld(&bar[XB_TMO])) break; if (sp > XB_SPIN_CAP) { atomicAdd(&bar[XB_TMO], 1u); break; } }
    }
    nloc = mine > 0u ? mine : 1u; nx = cnt > 0u ? cnt : 1u;
}
DI void xcd_barrier(const XcdBarrier& b) {
    asm volatile("s_waitcnt vmcnt(0)" ::: "memory");
    __syncthreads();
    if (threadIdx.x == 0) {
        unsigned* bar = b.bar;
        __builtin_amdgcn_s_waitcnt(0);
        unsigned nloc = b.st[0], nx = b.st[1];
        if (nloc == 0u) { xcd_barrier_complete(bar, b.x, nloc, nx); b.st[0] = nloc; b.st[1] = nx; }
        const unsigned old = xb_add(&bar[XB_XSUB(b.x)], 1u);
        const unsigned gen = old / nloc;
        if (old + 1u == (gen + 1u) * nloc) {
            __builtin_amdgcn_fence(__ATOMIC_RELEASE, "agent");
            asm volatile("s_waitcnt vmcnt(0)" ::: "memory");
            const unsigned og = xb_add(&bar[XB_TOP], 1u);
            const unsigned tg = og / nx;
            if (og + 1u == (tg + 1u) * nx) xb_add(&bar[XB_TOPGEN], 1u);
            else XB_SPIN(xb_ld(&bar[XB_TOPGEN]) == tg, bar);
            __builtin_amdgcn_fence(__ATOMIC_ACQUIRE, "agent");
            xb_add(&bar[XB_XGEN(b.x)], 1u);
            asm volatile("s_waitcnt vmcnt(0)" ::: "memory");
        } else {
            XB_SPIN(xb_ld(&bar[XB_XGEN(b.x)]) == gen, bar);
            __builtin_amdgcn_fence(__ATOMIC_ACQUIRE, "agent");
            asm volatile("s_waitcnt vmcnt(0)" ::: "memory");
        }
    }
    __syncthreads();
}
constexpr size_t WS_BAR = 65536;

namespace pg8 {
constexpr int BM = 256, BK = 64, HALF = 128, HTB = HALF * BK * 2, STAGE_BYTES = 8 * HTB;
DI int lds_byte(int r, int c) { const int st = (r >> 4) * 2 + (c >> 5), rr = r & 15, cc = c & 31, ob = rr * 64 + cc * 2; return st * 1024 + (ob ^ (((ob >> 9) & 1) << 5)); }
DI void stage_rc(int b, int& R, int& C) { const int st = b / 1024, sb = b % 1024, swz = sb ^ (((sb >> 9) & 1) << 5); R = (st >> 1) * 16 + swz / 64; C = (st & 1) * 32 + (swz % 64) / 2; }
DI int perm32(int rho) { const int n = rho >> 4, i = rho & 15; return 8 * (i >> 2) + 4 * n + (i & 3); }
struct Unit { const char* A; const char* B; int pm, pn, sub; };
DI void tile_of(int L, int nM, int nN, int WGM, int& pm, int& pn) {
    const int nwg = nM * nN; int wgid = L;
    { const int q = nwg / 8, r = nwg % 8, xcd = wgid % 8, off = wgid / 8; wgid = (xcd < r ? xcd * (q + 1) : r * (q + 1) + (xcd - r) * q) + off; }
    const int nig = WGM * nN, gid = wgid / nig, fm = gid * WGM, gsz = (nM - fm) < WGM ? (nM - fm) : WGM;
    pm = fm + ((wgid % nig) % gsz); pn = (wgid % nig) / gsz;
}
struct SchedPlain {
    const char* A; const char* Bt; int nM, nN, K, G, c, wgm;
    DI bool next(int i, Unit& u) const {
        const long L = (long)i * G + c; if (L >= (long)nM * nN) return false;
        tile_of((int)L, nM, nN, wgm, u.pm, u.pn); u.sub = 0;
        u.A = A + (size_t)u.pm * 256 * K * 2; u.B = Bt + (size_t)u.pn * 256 * K * 2; return true;
    }
};
struct SchedDual {
    const char *A0, *B0, *A1, *B1; int nM, nN, K, G, c;
    DI bool next(int i, Unit& u) const {
        const long L = (long)(i >> 1) * G + c; if (L >= (long)nM * nN) return false;
        tile_of((int)L, nM, nN, 4, u.pm, u.pn); u.sub = i & 1;
        u.A = (u.sub ? A1 : A0) + (size_t)u.pm * 256 * K * 2; u.B = (u.sub ? B1 : B0) + (size_t)u.pn * 256 * K * 2; return true;
    }
};

template <class Epi, class Sched>
DI void gemm_phase(LAS unsigned char* lds, const int K, const Sched& S, const Epi& E) {
    const int tid = threadIdx.x, wid = __builtin_amdgcn_readfirstlane(tid >> 6), lane = tid & 63, wr = wid >> 2, wc = wid & 3, fr = lane & 15, fq = lane >> 4;
    const int nt = K / BK;
    unsigned voffA[2], voffB[2];
#pragma unroll
    for (int i = 0; i < 2; ++i) { int R, C; stage_rc(tid * 16 + i * 8192, R, C); const int Rb = (R & ~31) + perm32(R & 31);
        voffA[i] = (unsigned)(R * K + C) * 2u; voffB[i] = (unsigned)(Rb * K + C) * 2u; }
    const size_t kstep = (size_t)(BK * 2);
    const size_t hstep = (size_t)HALF * K * 2;
    const unsigned ldsw = (unsigned)wid * 1024u;
    const int aoff = lds_byte(wr * 64 + fr, fq * 8), boff = lds_byte(wc * 32 + fr, fq * 8);
#define PG8_SA(b, h) (((b) * 2 + (h)) * HTB)
#define PG8_SB(b, h) ((4 + (b) * 2 + (h)) * HTB)
#define PG8_STAGE(bufoff, gbase, voff) do { _Pragma("unroll") for (int _i = 0; _i < 2; ++_i) \
        __builtin_amdgcn_global_load_lds((const unsigned*)((const char*)(gbase) + (voff)[_i]), (LAS unsigned*)(lds + (bufoff) + ldsw + _i * 8192), 16, 0, 0); } while (0)
#define PG8_LDA(dst, b, h) do { _Pragma("unroll") for (int m = 0; m < 4; ++m) _Pragma("unroll") for (int k = 0; k < 2; ++k) dst[m][k] = *(const LAS bf16x8*)(lds + PG8_SA(b, h) + aoff + m * 2048 + k * 1024); } while (0)
#define PG8_LDB(dst, b, h) do { _Pragma("unroll") for (int n = 0; n < 2; ++n) _Pragma("unroll") for (int k = 0; k < 2; ++k) dst[n][k] = *(const LAS bf16x8*)(lds + PG8_SB(b, h) + boff + n * 2048 + k * 1024); } while (0)
#define PG8_MMA(ai, bj, At, Bt) do { __builtin_amdgcn_s_setprio(1); _Pragma("unroll") for (int m = 0; m < 4; ++m) _Pragma("unroll") for (int n = 0; n < 2; ++n) _Pragma("unroll") for (int k = 0; k < 2; ++k) \
        acc[ai][bj][m][n] = __builtin_amdgcn_mfma_f32_16x16x32_bf16(Bt[n][k], At[m][k], acc[ai][bj][m][n], 0, 0, 0); __builtin_amdgcn_s_setprio(0); } while (0)
#define PG8_WAIT_V(n) asm volatile("s_waitcnt vmcnt(" #n ")" ::: "memory")
#define PG8_WAIT_L(n) asm volatile("s_waitcnt lgkmcnt(" #n ")" ::: "memory")
#define PG8_BAR __builtin_amdgcn_s_barrier()
#define PG8_SCHED __builtin_amdgcn_sched_barrier(0)
    Unit cur, nxt; int ui = 0;
    if (!S.next(0, cur)) return;
    f32x4 acc[2][2][4][2];
#pragma unroll
    for (int a = 0; a < 2; ++a)
#pragma unroll
        for (int b = 0; b < 2; ++b)
#pragma unroll
            for (int m = 0; m < 4; ++m)
#pragma unroll
                for (int n = 0; n < 2; ++n) acc[a][b][m][n] = (f32x4){0.f, 0.f, 0.f, 0.f};
    bf16x8 At[4][2], B0[2][2], B1[2][2];
    const char* cA = cur.A; const char* cB = cur.B;
    PG8_STAGE(PG8_SB(0, 0), cB, voffB); PG8_STAGE(PG8_SA(0, 0), cA, voffA); PG8_STAGE(PG8_SB(0, 1), cB + hstep, voffB); PG8_STAGE(PG8_SA(0, 1), cA + hstep, voffA);
    if (wr == 1) PG8_BAR;
    PG8_WAIT_V(4); PG8_BAR;
    PG8_STAGE(PG8_SB(1, 0), cB + kstep, voffB); PG8_STAGE(PG8_SA(1, 0), cA + kstep, voffA); PG8_STAGE(PG8_SB(1, 1), cB + hstep + kstep, voffB);
    PG8_WAIT_V(6); PG8_BAR;
    for (;;) {
        const bool has_next = S.next(ui + 1, nxt);
        const char* nA = has_next ? nxt.A : cA; const char* nB = has_next ? nxt.B : cB;
        for (int t = 0; t < nt; t += 2) {
            const bool last = (t == nt - 2);
            const char* a1 = cA + (size_t)(t + 1) * kstep;
            const char* a2 = last ? nA : cA + (size_t)(t + 2) * kstep; const char* b2 = last ? nB : cB + (size_t)(t + 2) * kstep;
            const char* a3 = a2 + kstep; const char* b3 = b2 + kstep;
            PG8_LDB(B0, 0, 0); PG8_SCHED; PG8_LDA(At, 0, 0); PG8_STAGE(PG8_SA(1, 1), a1 + hstep, voffA);
            PG8_WAIT_L(8); PG8_BAR; PG8_WAIT_L(0); PG8_MMA(0, 0, At, B0); PG8_BAR; PG8_SCHED;
            PG8_LDB(B1, 0, 1); PG8_STAGE(PG8_SB(0, 0), b2, voffB);
            PG8_BAR; PG8_WAIT_L(0); PG8_MMA(0, 1, At, B1); PG8_BAR;
            PG8_LDA(At, 0, 1); PG8_STAGE(PG8_SA(0, 0), a2, voffA);
            PG8_BAR; PG8_WAIT_L(0); PG8_MMA(1, 0, At, B0); PG8_BAR; PG8_SCHED;
            PG8_STAGE(PG8_SB(0, 1), b2 + hstep, voffB);
            PG8_WAIT_V(6); PG8_BAR; PG8_MMA(1, 1, At, B1); PG8_BAR;
            PG8_LDB(B0, 1, 0); PG8_SCHED; PG8_LDA(At, 1, 0); PG8_STAGE(PG8_SA(0, 1), a2 + hstep, voffA);
            PG8_WAIT_L(8); PG8_BAR; PG8_WAIT_L(0); PG8_MMA(0, 0, At, B0); PG8_BAR; PG8_SCHED;
            PG8_LDB(B1, 1, 1); PG8_STAGE(PG8_SB(1, 0), b3, voffB);
            PG8_BAR; PG8_WAIT_L(0); PG8_MMA(0, 1, At, B1); PG8_BAR;
            PG8_LDA(At, 1, 1); PG8_STAGE(PG8_SA(1, 0), a3, voffA);
            PG8_BAR; PG8_WAIT_L(0); PG8_MMA(1, 0, At, B0); PG8_BAR; PG8_SCHED;
            PG8_STAGE(PG8_SB(1, 1), b3 + hstep, voffB);
            PG8_WAIT_V(6); PG8_BAR; PG8_MMA(1, 1, At, B1); PG8_BAR;
        }
        E(acc, cur, wr, wc, fr, fq);
        if (!has_next) break;
        if (!E.keep(cur))
#pragma unroll
        for (int a = 0; a < 2; ++a)
#pragma unroll
            for (int b = 0; b < 2; ++b)
#pragma unroll
                for (int m = 0; m < 4; ++m)
#pragma unroll
                    for (int n = 0; n < 2; ++n) acc[a][b][m][n] = (f32x4){0.f, 0.f, 0.f, 0.f};
        cur = nxt; cA = nA; cB = nB; ++ui;
    }
    PG8_WAIT_V(0);
    if (wr == 0) PG8_BAR;
    PG8_BAR;
#undef PG8_SA
#undef PG8_SB
#undef PG8_STAGE
#undef PG8_LDA
#undef PG8_LDB
#undef PG8_MMA
#undef PG8_WAIT_V
#undef PG8_WAIT_L
#undef PG8_BAR
#undef PG8_SCHED
}
}
using pg8::Unit;
typedef f32x4 Acc[2][2][4][2];

DI u32x4 pack8(const f32x4& a, const f32x4& b) { u32x4 w; w.x = pk2(a[0], a[1]); w.y = pk2(a[2], a[3]); w.z = pk2(b[0], b[1]); w.w = pk2(b[2], b[3]); return w; }

struct Epi1 {
    DI bool keep(const Unit&) const { return false; }
    bf16_t *QS, *KK, *VI, *SG, *QB, *KB, *VB, *GA, *GB; float* LOGF; const float* lbl; const float* bgate;
    DI void operator()(const Acc& acc, const Unit& u, int wr, int wc, int fr, int fq) const {
        const int colt = u.pn * 256, sec = colt >> 10, row0 = u.pm * 256 + wr * 64 + fr, cw = wc * 32 + 8 * fq;
        if (sec == 1) {
#pragma unroll
            for (int bj = 0; bj < 2; ++bj) {
                const int c = colt - 1024 + bj * 128 + cw;
                const f32x4 l0a = *(const f32x4*)(lbl + c), l0b = *(const f32x4*)(lbl + c + 4), l1a = *(const f32x4*)(lbl + 1024 + c), l1b = *(const f32x4*)(lbl + 1024 + c + 4);
                float lb[8];
#pragma unroll
                for (int j = 0; j < 4; ++j) { lb[j] = sigm(l0a[j] - l1a[j]); lb[4 + j] = sigm(l0b[j] - l1b[j]); }
#pragma unroll
                for (int ai = 0; ai < 2; ++ai)
#pragma unroll
                    for (int m = 0; m < 4; ++m) {
                        const size_t o = (size_t)(row0 + ai * 128 + m * 16) * 1024 + c;
                        f32x4 lf[2];
#pragma unroll
                        for (int n = 0; n < 2; ++n)
#pragma unroll
                            for (int j = 0; j < 4; ++j) {
                                const float z = fmaxf(acc[ai][bj][m][n][j], -30.f), e = __expf(-z), sg = __builtin_amdgcn_rcpf(1.f + e), l = lb[4 * n + j];
                                lf[n][j] = __logf(l + (1.f - l) * sg);
                            }
                        *(u32x4*)((_Float16*)LOGF + o) = (u32x4){pkh2(lf[0][0], lf[0][1]), pkh2(lf[0][2], lf[0][3]), pkh2(lf[1][0], lf[1][1]), pkh2(lf[1][2], lf[1][3])};
                    }
            }
            return;
        }
        if (sec >= 7) {
            unsigned char* dst8 = (unsigned char*)(sec < 9 ? GA : GB); const int coff8 = colt - (sec < 9 ? 7168 : 9216);
#pragma unroll
            for (int bj = 0; bj < 2; ++bj) {
                const int bc = colt - 7168 + bj * 128 + cw; const f32x4 b0 = *(const f32x4*)(bgate + bc), b1 = *(const f32x4*)(bgate + bc + 4);
#pragma unroll
                for (int ai = 0; ai < 2; ++ai)
#pragma unroll
                    for (int m = 0; m < 4; ++m) {
                        unsigned q[8];
#pragma unroll
                        for (int j = 0; j < 4; ++j) { q[j] = (unsigned)(sigm(acc[ai][bj][m][0][j] + b0[j]) * 255.f + 0.5f); q[4 + j] = (unsigned)(sigm(acc[ai][bj][m][1][j] + b1[j]) * 255.f + 0.5f); }
                        u32x2 w; w.x = q[0] | (q[1] << 8) | (q[2] << 16) | (q[3] << 24); w.y = q[4] | (q[5] << 8) | (q[6] << 16) | (q[7] << 24);
                        *(u32x2*)(dst8 + (size_t)(row0 + ai * 128 + m * 16) * 2048 + coff8 + bj * 128 + cw) = w;
                    }
            }
            return;
        }
        bf16_t* dst; int ld = 1024, coff, mode = 0;
        if (sec == 0) { dst = QS; coff = colt; }
        else if (sec == 2) { dst = VI; coff = colt - 2048; }
        else if (sec == 3) { dst = SG; coff = colt - 3072; }
        else if (sec == 4) { dst = QB; coff = colt - 4096; }
        else if (sec == 5) { dst = KB; coff = colt - 5120; }
        else { dst = VB; coff = colt - 6144; }
#pragma unroll
        for (int bj = 0; bj < 2; ++bj) {
            const int c = coff + bj * 128 + cw;
            f32x4 b0 = (f32x4){0.f, 0.f, 0.f, 0.f}, b1 = b0;
            if (mode == 2) { const int bc = colt - 7168 + bj * 128 + cw; b0 = *(const f32x4*)(bgate + bc); b1 = *(const f32x4*)(bgate + bc + 4); }
#pragma unroll
            for (int ai = 0; ai < 2; ++ai)
#pragma unroll
                for (int m = 0; m < 4; ++m) {
                    f32x4 v0 = acc[ai][bj][m][0], v1 = acc[ai][bj][m][1];
                    if (mode == 1) {
#pragma unroll
                        for (int j = 0; j < 4; ++j) { v0[j] = silu(v0[j]); v1[j] = silu(v1[j]); }
                    } else if (mode == 2) {
#pragma unroll
                        for (int j = 0; j < 4; ++j) { v0[j] = sigm(v0[j] + b0[j]); v1[j] = sigm(v1[j] + b1[j]); }
                    }
                    *(u32x4*)(dst + (size_t)(row0 + ai * 128 + m * 16) * ld + c) = pack8(v0, v1);
                }
        }
    }
};
struct Epi3 {
    const unsigned char *GA, *GB; bf16_t* MERGED;
    DI bool keep(const Unit& u) const { return u.sub == 0; }
    DI void operator()(Acc& acc, const Unit& u, int wr, int wc, int fr, int fq) const {
        const int row0 = u.pm * 256 + wr * 64 + fr, c0 = u.pn * 256 + wc * 32 + 8 * fq;
#pragma unroll
        for (int ai = 0; ai < 2; ++ai) {
            u32x2 ga[4][2], gb[4][2];
#pragma unroll
            for (int m = 0; m < 4; ++m)
#pragma unroll
                for (int bj = 0; bj < 2; ++bj) {
                    const size_t o = (size_t)(row0 + ai * 128 + m * 16) * DM + c0 + bj * 128;
                    gb[m][bj] = *(const u32x2*)(GB + o);
                    if (u.sub == 0) ga[m][bj] = *(const u32x2*)(GA + o);
                }
#pragma unroll
            for (int m = 0; m < 4; ++m)
#pragma unroll
                for (int bj = 0; bj < 2; ++bj) {
                    const unsigned bw[2] = {gb[m][bj].x, gb[m][bj].y};
                    float fb[8];
#pragma unroll
                    for (int j = 0; j < 8; ++j) fb[j] = fmaxf((float)((bw[j >> 2] >> (8 * (j & 3))) & 0xffu), 0.5f);
                    if (u.sub == 0) {
                        const unsigned aw[2] = {ga[m][bj].x, ga[m][bj].y};
#pragma unroll
                        for (int j = 0; j < 8; ++j) acc[ai][bj][m][j >> 2][j & 3] *= (float)((aw[j >> 2] >> (8 * (j & 3))) & 0xffu) * __builtin_amdgcn_rcpf(fb[j]);
                    } else {
                        const size_t o = (size_t)(row0 + ai * 128 + m * 16) * DM + c0 + bj * 128;
                        f32x4 v0 = acc[ai][bj][m][0], v1 = acc[ai][bj][m][1];
#pragma unroll
                        for (int j = 0; j < 4; ++j) { v0[j] *= fb[j] * (1.f / 255.f); v1[j] *= fb[4 + j] * (1.f / 255.f); }
                        *(u32x4*)(MERGED + o) = pack8(v0, v1);
                    }
                }
        }
    }
};
struct Epi4 {
    DI bool keep(const Unit&) const { return false; }
    const float* x; float* out; bf16_t* X1B; float* rowss;
    DI void operator()(const Acc& acc, const Unit& u, int wr, int wc, int fr, int fq) const {
        const int row0 = u.pm * 256 + wr * 64 + fr, c0 = u.pn * 256 + wc * 32 + 8 * fq;
#pragma unroll
        for (int ai = 0; ai < 2; ++ai)
            {
                constexpr int mp = 0;
                f32x4 x0[4][2], x1[4][2];
#pragma unroll
                for (int mm = 0; mm < 4; ++mm)
#pragma unroll
                    for (int bj = 0; bj < 2; ++bj) {
                        const size_t o = (size_t)(row0 + ai * 128 + (2 * mp + mm) * 16) * DM + c0 + bj * 128;
                        x0[mm][bj] = *(const f32x4*)(x + o); x1[mm][bj] = *(const f32x4*)(x + o + 4);
                    }
#pragma unroll
                for (int mm = 0; mm < 4; ++mm) {
                    const int m = 2 * mp + mm, row = row0 + ai * 128 + m * 16; float ss = 0.f;
#pragma unroll
                    for (int bj = 0; bj < 2; ++bj) {
                        const size_t o = (size_t)row * DM + c0 + bj * 128;
                        const f32x4 v0 = acc[ai][bj][m][0] + x0[mm][bj], v1 = acc[ai][bj][m][1] + x1[mm][bj];
                        *(u32x4*)(X1B + o) = pack8(v0, v1);
                        ss += (v0[0] * v0[0] + v0[1] * v0[1]) + (v0[2] * v0[2] + v0[3] * v0[3]) + (v1[0] * v1[0] + v1[1] * v1[1]) + (v1[2] * v1[2] + v1[3] * v1[3]);
                    }
                    ss += __shfl_xor(ss, 16); ss += __shfl_xor(ss, 32);
                    if (fq == 0) atomicAdd(rowss + row, ss);
                }
            }
    }
};
struct Epi5 {
    DI bool keep(const Unit&) const { return false; }
    const float* rowss; bf16_t* ACT;
    DI void operator()(const Acc& acc, const Unit& u, int wr, int wc, int fr, int fq) const {
        const int row0 = u.pm * 256 + wr * 64 + fr, c0 = u.pn * 128 + wc * 32 + 8 * fq;
        float rsv[2][4];
#pragma unroll
        for (int ai = 0; ai < 2; ++ai)
#pragma unroll
            for (int m = 0; m < 4; ++m) rsv[ai][m] = rowss[row0 + ai * 128 + m * 16];
#pragma unroll
        for (int ai = 0; ai < 2; ++ai)
#pragma unroll
            for (int m = 0; m < 4; ++m) {
                const int row = row0 + ai * 128 + m * 16;
                const float rs = rsqrtf(rsv[ai][m] * (1.f / DM) + EPS);
                f32x4 a0, a1;
#pragma unroll
                for (int j = 0; j < 4; ++j) { a0[j] = silu(acc[ai][0][m][0][j] * rs) * (acc[ai][1][m][0][j] * rs); a1[j] = silu(acc[ai][0][m][1][j] * rs) * (acc[ai][1][m][1][j] * rs); }
                *(u32x4*)(ACT + (size_t)row * DFF + c0) = pack8(a0, a1);
            }
    }
};
struct EpiNull {
    DI bool keep(const Unit&) const { return false; } float* sink;
    DI void operator()(const Acc& acc, const Unit& u, int wr, int wc, int fr, int fq) const {
        float t = 0.f;
#pragma unroll
        for (int ai = 0; ai < 2; ++ai)
#pragma unroll
            for (int bj = 0; bj < 2; ++bj)
#pragma unroll
                for (int m = 0; m < 4; ++m)
#pragma unroll
                    for (int n = 0; n < 2; ++n) t += acc[ai][bj][m][n][0] + acc[ai][bj][m][n][1] + acc[ai][bj][m][n][2] + acc[ai][bj][m][n][3];
        if (t == 12345.678f) sink[0] = t;
    }
};
struct Epi6 {
    DI bool keep(const Unit&) const { return false; }
    const bf16_t* X1B; float* out;
    DI void operator()(const Acc& acc, const Unit& u, int wr, int wc, int fr, int fq) const {
        const int row0 = u.pm * 256 + wr * 64 + fr, c0 = u.pn * 256 + wc * 32 + 8 * fq;
#pragma unroll
        for (int ai = 0; ai < 2; ++ai) {
            u32x4 xb[4][2];
#pragma unroll
            for (int m = 0; m < 4; ++m)
#pragma unroll
                for (int bj = 0; bj < 2; ++bj) xb[m][bj] = *(const u32x4*)(X1B + (size_t)(row0 + ai * 128 + m * 16) * DM + c0 + bj * 128);
#pragma unroll
            for (int m = 0; m < 4; ++m)
#pragma unroll
                for (int bj = 0; bj < 2; ++bj) {
                    const size_t o = (size_t)(row0 + ai * 128 + m * 16) * DM + c0 + bj * 128; const u32x4 t = xb[m][bj];
                    f32x4 v0 = acc[ai][bj][m][0], v1 = acc[ai][bj][m][1];
                    v0[0] += bflo(t.x); v0[1] += bfhi(t.x); v0[2] += bflo(t.y); v0[3] += bfhi(t.y); v1[0] += bflo(t.z); v1[1] += bfhi(t.z); v1[2] += bflo(t.w); v1[3] += bfhi(t.w);
                    *(f32x4*)(out + o) = v0; *(f32x4*)(out + o + 4) = v1;
                }
        }
    }
};

DI void transpose_item(const float* W, int K, int N, bf16_t* WT, int dst_row0, const float* kscale, LAS float* scr, int k0, int n0, int lane) {
    float rr[32];
#pragma unroll
    for (int i = 0; i < 32; ++i) rr[i] = W[(size_t)(k0 + 2 * i + (lane >> 5)) * N + n0 + (lane & 31)];
#pragma unroll
    for (int i = 0; i < 32; ++i) scr[(2 * i + (lane >> 5)) * 33 + (lane & 31)] = rr[i];
    asm volatile("s_waitcnt lgkmcnt(0)" ::: "memory");
    const int c = lane & 7;
    float sc[8];
#pragma unroll
    for (int i = 0; i < 8; ++i) sc[i] = kscale ? kscale[k0 + 8 * c + i] : 1.f;
#pragma unroll
    for (int j = 0; j < 4; ++j) { const int n = (lane >> 3) + 8 * j; const LAS float* s = scr + (8 * c) * 33 + n;
        u32x4 o; o.x = pk2(s[0 * 33] * sc[0], s[1 * 33] * sc[1]); o.y = pk2(s[2 * 33] * sc[2], s[3 * 33] * sc[3]); o.z = pk2(s[4 * 33] * sc[4], s[5 * 33] * sc[5]); o.w = pk2(s[6 * 33] * sc[6], s[7 * 33] * sc[7]);
        *(u32x4*)(WT + (size_t)(dst_row0 + n) * K + k0 + 8 * c) = o; }
    asm volatile("s_waitcnt lgkmcnt(0)" ::: "memory");
}
constexpr int I_IN = (DM / 64) * (NIN / 32), I_PA = (DA / 64) * (DM / 32), I_O = (DM / 64) * (DM / 32), I_F1 = I_IN, I_F2 = (DFF / 64) * (DM / 32);
constexpr int NITEMS = I_IN + 2 * I_PA + I_O + I_F1 + I_F2;
DI void convert_items(LAS unsigned char* L, const Params& p, int lo, int hi, int gw, int NGW) {
    const int tid = threadIdx.x, lane = tid & 63, wave = __builtin_amdgcn_readfirstlane(tid >> 6);
    LAS float* scr = (LAS float*)(L + wave * 16384);
    unsigned char* ws = p.ws;
    for (int it = lo + gw; it < hi; it += NGW) {
        int r = it;
        if (r < I_IN) { const int nblk = NIN / 32, kb = r / nblk, nb = r % nblk; transpose_item(p.in[1], DM, NIN, (bf16_t*)(ws + WS_WIN), 32 * nb, nullptr, scr, 64 * kb, 32 * nb, lane); continue; } r -= I_IN;
        if (r < I_PA) { const int nblk = DM / 32, kb = r / nblk, nb = r % nblk; transpose_item(p.in[10], DA, DM, (bf16_t*)(ws + WS_WPA), 32 * nb, nullptr, scr, 64 * kb, 32 * nb, lane); continue; } r -= I_PA;
        if (r < I_PA) { const int nblk = DM / 32, kb = r / nblk, nb = r % nblk; transpose_item(p.in[11], DA, DM, (bf16_t*)(ws + WS_WPB), 32 * nb, nullptr, scr, 64 * kb, 32 * nb, lane); continue; } r -= I_PA;
        if (r < I_O) { const int nblk = DM / 32, kb = r / nblk, nb = r % nblk; transpose_item(p.in[12], DM, DM, (bf16_t*)(ws + WS_WO), 32 * nb, nullptr, scr, 64 * kb, 32 * nb, lane); continue; } r -= I_O;
        if (r < I_F1) { const int nblk = NIN / 32, kb = r / nblk, nb = r % nblk; const int n0 = 32 * nb;
            const int nn = n0 < DFF ? n0 : n0 - DFF; const int drow = 256 * (nn >> 7) + (n0 < DFF ? 0 : 128) + (nn & 127);
            transpose_item(p.in[13], DM, NIN, (bf16_t*)(ws + WS_WF1), drow, p.in[4], scr, 64 * kb, n0, lane); continue; } r -= I_F1;
        { const int nblk = DM / 32, kb = r / nblk, nb = r % nblk; transpose_item(p.in[14], DFF, DM, (bf16_t*)(ws + WS_WF2), 32 * nb, nullptr, scr, 64 * kb, 32 * nb, lane); }
    }
}
DI void p0_prologue(LAS unsigned char* L, const Params& p, int G, int items_hi) {
    const int tid = threadIdx.x, lane = tid & 63, wave = __builtin_amdgcn_readfirstlane(tid >> 6);
    const int gw = blockIdx.x * 8 + wave, NGW = G * 8;
    unsigned char* ws = p.ws;
    convert_items(L, p, 0, items_hi, gw, NGW);
    bf16_t* H = (bf16_t*)p.out; const float* x = p.in[0]; const float* gain = p.in[3];
    for (int m = gw; m < MTOK; m += NGW) {
        const f32x4* xr = (const f32x4*)(x + (size_t)m * DM) + lane;
        f32x4 v[8]; float s = 0.f;
#pragma unroll
        for (int j = 0; j < 8; ++j) { v[j] = xr[64 * j]; s += (v[j][0] * v[j][0] + v[j][1] * v[j][1]) + (v[j][2] * v[j][2] + v[j][3] * v[j][3]); }
#pragma unroll
        for (int o = 1; o < 64; o <<= 1) s += __shfl_xor(s, o);
        const float rstd = rsqrtf(s * (1.f / DM) + EPS);
        u32x2* o8 = (u32x2*)(H + (size_t)m * DM) + lane;
#pragma unroll
        for (int j = 0; j < 8; ++j) { const f32x4 g = *((const f32x4*)gain + lane + 64 * j); u32x2 w; w.x = pk2(v[j][0] * rstd * g[0], v[j][1] * rstd * g[1]); w.y = pk2(v[j][2] * rstd * g[2], v[j][3] * rstd * g[3]); o8[64 * j] = w; }
    }
    float* rowss = (float*)(ws + WS_CTL);
    for (int i = blockIdx.x * 512 + tid; i < MTOK; i += G * 512) rowss[i] = 0.f;
}

DI void lds_barrier() { asm volatile("s_waitcnt lgkmcnt(0)" ::: "memory"); __builtin_amdgcn_s_barrier(); asm volatile("" ::: "memory"); }
DI bf16x8 ldfrag(const LAS bf16_t* base, int stride, int row, int k) { return *(const LAS bf16x8*)(base + row * stride + k); }
struct LocRegs { unsigned lfh[8]; unsigned q[8], v[8]; };
DI void local_load(LocRegs& r, const Params& p, int it, int tid) {
    const int bh = it >> 5, j = it & 31, b = bh >> 3, h = bh & 7, cp = tid & 63, rg = tid >> 6;
    const size_t g = ((size_t)b * SEQ + 64 * j + 8 * rg) * 1024 + h * 128 + 2 * cp;
    const float* LOGF = (const float*)(p.ws + WS_LOGF); const bf16_t* QS = (const bf16_t*)(p.ws + WS_QS); const bf16_t* KKp = (const bf16_t*)(p.ws + WS_KK); const bf16_t* VI = (const bf16_t*)(p.ws + WS_VI);
#pragma unroll
    for (int i = 0; i < 8; ++i) { r.lfh[i] = *(const unsigned*)((const _Float16*)LOGF + g + (size_t)i * 1024); r.q[i] = *(const unsigned*)(QS + g + (size_t)i * 1024);
        r.v[i] = *(const unsigned*)(VI + g + (size_t)i * 1024); }
}
DI void hgrn_local(LAS unsigned char* L, const Params& p, int it, const LocRegs& r) {
    const int tid = threadIdx.x, lane = tid & 63, w = __builtin_amdgcn_readfirstlane(tid >> 6), fr = lane & 15, fq = lane >> 4;
    const int bh = it >> 5, j = it & 31, b = bh >> 3, h = bh & 7, cp = lane, rg = w;
    unsigned char* ws = p.ws;
    bf16_t* QEg = (bf16_t*)(ws + WS_QEG); float* EVg = (float*)(ws + WS_EV) + (size_t)it * 256;
    u32x2* OIg = (u32x2*)((unsigned char*)p.out + OUT_OI); u32x4* Ug = (u32x4*)((unsigned char*)p.out + OUT_U);
    LAS bf16_t* QE = (LAS bf16_t*)(L + 0); LAS bf16_t* KE = (LAS bf16_t*)(L + 17408); LAS bf16_t* KET = (LAS bf16_t*)(L + 34816); LAS bf16_t* VT = (LAS bf16_t*)(L + 53248);
    LAS bf16_t* PP = (LAS bf16_t*)(L + 71680); LAS float* TOT = (LAS float*)(L + 115712);
    const int tb = w >> 1, wh = w & 1;
    const size_t tok0 = (size_t)b * SEQ + 64 * j;
    float c0[8], c1[8]; float r0 = 0.f, r1 = 0.f;
    float l0[8], l1[8];
#pragma unroll
    for (int i = 0; i < 8; ++i) { const f16x2_t hv = __builtin_bit_cast(f16x2_t, r.lfh[i]); l0[i] = (float)hv[0]; l1[i] = (float)hv[1]; r0 += l0[i]; r1 += l1[i]; c0[i] = r0; c1[i] = r1; }
    *(LAS f32x2*)(TOT + rg * 128 + 2 * cp) = (f32x2){r0, r1};
    lds_barrier();
    f32x2 pre = (f32x2){0.f, 0.f}, post = pre, off = pre;
#pragma unroll
    for (int g = 0; g < 8; ++g) { const f32x2 t = *(const LAS f32x2*)(TOT + g * 128 + 2 * cp);
        if (g < 4) { pre += t; if (g >= rg) off -= t; } else { post += t; if (g < rg) off += t; } }
    float k0s[8], k1s[8];
#pragma unroll
    for (int i = 0; i < 8; ++i) {
        const float e0 = c0[i] + off[0], e1 = c1[i] + off[1];
        const float qe0 = silu(bflo(r.q[i])) * __expf(fminf(e0, 60.f)), qe1 = silu(bfhi(r.q[i])) * __expf(fminf(e1, 60.f));
        k0s[i] = (1.f - __expf(l0[i])) * __expf(fminf(-e0, 60.f)); k1s[i] = (1.f - __expf(l1[i])) * __expf(fminf(-e1, 60.f));
        *(LAS unsigned*)(QE + (8 * rg + i) * 136 + 2 * cp) = pk2(qe0, qe1); *(LAS unsigned*)(KE + (8 * rg + i) * 136 + 2 * cp) = pk2(k0s[i], k1s[i]);
    }
    *(LAS u32x4*)(KET + (2 * cp) * 72 + 8 * rg) = (u32x4){pk2(k0s[0], k0s[1]), pk2(k0s[2], k0s[3]), pk2(k0s[4], k0s[5]), pk2(k0s[6], k0s[7])};
    *(LAS u32x4*)(KET + (2 * cp + 1) * 72 + 8 * rg) = (u32x4){pk2(k1s[0], k1s[1]), pk2(k1s[2], k1s[3]), pk2(k1s[4], k1s[5]), pk2(k1s[6], k1s[7])};
    *(LAS u32x4*)(VT + (2 * cp) * 72 + 8 * rg) = (u32x4){(r.v[0] & 0xffffu) | (r.v[1] << 16), (r.v[2] & 0xffffu) | (r.v[3] << 16), (r.v[4] & 0xffffu) | (r.v[5] << 16), (r.v[6] & 0xffffu) | (r.v[7] << 16)};
    *(LAS u32x4*)(VT + (2 * cp + 1) * 72 + 8 * rg) = (u32x4){(r.v[0] >> 16) | (r.v[1] & 0xffff0000u), (r.v[2] >> 16) | (r.v[3] & 0xffff0000u), (r.v[4] >> 16) | (r.v[5] & 0xffff0000u), (r.v[6] >> 16) | (r.v[7] & 0xffff0000u)};
    if (rg == 0) { *(f32x2*)(EVg + 2 * cp) = (f32x2){__expf(pre[0]), __expf(pre[1])}; *(f32x2*)(EVg + 128 + 2 * cp) = (f32x2){__expf(post[0]), __expf(post[1])}; }
    lds_barrier();
    {
        const int row = tid >> 3, c8 = (tid & 7) * 16;
        const int ksb = c8 & ~31, q0 = (c8 & 31) >> 3;
        const LAS bf16_t* src = QE + row * 136 + ksb;
        const u32x2 l0 = *(const LAS u32x2*)(src + 4 * q0), h0 = *(const LAS u32x2*)(src + 16 + 4 * q0), l1 = *(const LAS u32x2*)(src + 4 * q0 + 4), h1 = *(const LAS u32x2*)(src + 16 + 4 * q0 + 4);
        bf16_t* g = QEg + (tok0 + row) * 1024 + h * 128 + c8; *(u32x4*)g = (u32x4){l0.x, l0.y, h0.x, h0.y}; *(u32x4*)(g + 8) = (u32x4){l1.x, l1.y, h1.x, h1.y};
    }
    {
        bf16x8 qf[4];
#pragma unroll
        for (int ks = 0; ks < 4; ++ks) qf[ks] = ldfrag(QE, 136, 16 * tb + fr, 32 * ks + 8 * fq);
#pragma unroll
        for (int sbi = 0; sbi < 2; ++sbi) {
            const int sb = 2 * wh + sbi; f32x4 a = (f32x4){0.f, 0.f, 0.f, 0.f};
            if (sb <= tb) {
#pragma unroll
                for (int ks = 0; ks < 4; ++ks) a = MFMA16(ldfrag(KE, 136, 16 * sb + fr, 32 * ks + 8 * fq), qf[ks], a);
                if (sb == tb) {
#pragma unroll
                    for (int jj = 0; jj < 4; ++jj) if (4 * fq + jj > fr) a[jj] = 0.f;
                }
            }
            u32x2 o; o.x = pk2(a[0], a[1]); o.y = pk2(a[2], a[3]); *(LAS u32x2*)(PP + (16 * tb + fr) * 72 + 16 * sb + 4 * fq) = o;
        }
    }
    lds_barrier();
    {
        bf16x8 pf[2];
#pragma unroll
        for (int ks = 0; ks < 2; ++ks) pf[ks] = ldfrag(PP, 72, 16 * tb + fr, 32 * ks + 8 * fq);
#pragma unroll
        for (int i = 0; i < 4; ++i) { const int vb = 4 * wh + i; f32x4 a = (f32x4){0.f, 0.f, 0.f, 0.f};
#pragma unroll
            for (int ks = 0; ks < 2; ++ks) a = MFMA16(ldfrag(VT, 72, 16 * vb + fr, 32 * ks + 8 * fq), pf[ks], a);
            u32x2 ob; ob.x = pk2(a[0], a[1]); ob.y = pk2(a[2], a[3]); OIg[((size_t)(it * 8 + w) * 4 + i) * 64 + lane] = ob; }
        bf16x8 kf[2][2];
#pragma unroll
        for (int kb = 0; kb < 2; ++kb)
#pragma unroll
            for (int ks = 0; ks < 2; ++ks) kf[kb][ks] = ldfrag(KET, 72, 32 * tb + 16 * kb + fr, 32 * ks + 8 * fq);
#pragma unroll
        for (int v4 = 0; v4 < 4; ++v4) { const int vb = 4 * wh + v4; f32x4 a0 = (f32x4){0.f, 0.f, 0.f, 0.f}, a1 = a0;
#pragma unroll
            for (int ks = 0; ks < 2; ++ks) { const bf16x8 vf = ldfrag(VT, 72, 16 * vb + fr, 32 * ks + 8 * fq); a0 = MFMA16(kf[0][ks], vf, a0); a1 = MFMA16(kf[1][ks], vf, a1); }
            Ug[((size_t)(it * 8 + w) * 4 + v4) * 64 + lane] = pack8(a0, a1); }
    }
    lds_barrier();
}

struct SStage { u32x4 U[4]; f32x4 er0, er1, el0, el1; };
DI void sscan_load(SStage& r, const Params& p, int it, int w, int lane) {
    const u32x4* Ug = (const u32x4*)((unsigned char*)p.out + OUT_U); const float* EVg = (const float*)(p.ws + WS_EV) + (size_t)it * 256; const int fq = lane >> 4, k0 = 32 * (w >> 1) + 4 * fq;
#pragma unroll
    for (int v4 = 0; v4 < 4; ++v4) r.U[v4] = Ug[((size_t)(it * 8 + w) * 4 + v4) * 64 + lane];
    r.er0 = *(const f32x4*)(EVg + k0); r.er1 = *(const f32x4*)(EVg + k0 + 16); r.el0 = *(const f32x4*)(EVg + 128 + k0); r.el1 = *(const f32x4*)(EVg + 128 + k0 + 16);
}
DI void sscan_step(f32x4 (&S)[4][2], const SStage& r, u32x4* SSC, int it, int w, int lane) {
#pragma unroll
    for (int v4 = 0; v4 < 4; ++v4) {
        S[v4][0] *= r.er0; S[v4][1] *= r.er1;
        SSC[((size_t)(it * 8 + w) * 4 + v4) * 64 + lane] = pack8(S[v4][0], S[v4][1]);
        const u32x4 u = r.U[v4];
        S[v4][0][0] = (S[v4][0][0] + bflo(u.x)) * r.el0[0]; S[v4][0][1] = (S[v4][0][1] + bfhi(u.x)) * r.el0[1]; S[v4][0][2] = (S[v4][0][2] + bflo(u.y)) * r.el0[2]; S[v4][0][3] = (S[v4][0][3] + bfhi(u.y)) * r.el0[3];
        S[v4][1][0] = (S[v4][1][0] + bflo(u.z)) * r.el1[0]; S[v4][1][1] = (S[v4][1][1] + bfhi(u.z)) * r.el1[1]; S[v4][1][2] = (S[v4][1][2] + bflo(u.w)) * r.el1[2]; S[v4][1][3] = (S[v4][1][3] + bfhi(u.w)) * r.el1[3];
    }
}
DI void hgrn_sscan(const Params& p, int bh) {
    const int tid = threadIdx.x, lane = tid & 63, w = __builtin_amdgcn_readfirstlane(tid >> 6);
    u32x4* SSC = (u32x4*)(p.ws + WS_SSC);
    f32x4 S[4][2];
#pragma unroll
    for (int i = 0; i < 4; ++i) { S[i][0] = (f32x4){0.f, 0.f, 0.f, 0.f}; S[i][1] = S[i][0]; }
    SStage r0, r1, r2, r3;
    const int it0 = bh * 32;
    sscan_load(r0, p, it0 + 0, w, lane); sscan_load(r1, p, it0 + 1, w, lane); sscan_load(r2, p, it0 + 2, w, lane); sscan_load(r3, p, it0 + 3, w, lane);
    for (int j = 0; j < 32; j += 4) {
        sscan_step(S, r0, SSC, it0 + j, w, lane);     if (j + 4 < 32) sscan_load(r0, p, it0 + j + 4, w, lane);
        sscan_step(S, r1, SSC, it0 + j + 1, w, lane); if (j + 5 < 32) sscan_load(r1, p, it0 + j + 5, w, lane);
        sscan_step(S, r2, SSC, it0 + j + 2, w, lane); if (j + 6 < 32) sscan_load(r2, p, it0 + j + 6, w, lane);
        sscan_step(S, r3, SSC, it0 + j + 3, w, lane); if (j + 7 < 32) sscan_load(r3, p, it0 + j + 7, w, lane);
    }
}
DI void hgrn_ointer(const Params& p, int bi) {
    const int tid = threadIdx.x, lane = tid & 63, w = __builtin_amdgcn_readfirstlane(tid >> 6), fr = lane & 15, fq = lane >> 4;
    const int it = 2 * bi + (w >> 2), tb = w & 3, bh = it >> 5, j = it & 31, b = bh >> 3, h = bh & 7;
    unsigned char* ws = p.ws;
    const bf16_t* QEg = (const bf16_t*)(ws + WS_QEG); const u32x4* SSC = (const u32x4*)(ws + WS_SSC); const bf16_t* SG = (const bf16_t*)(ws + WS_SG); bf16_t* YA = (bf16_t*)(ws + WS_YA);
    const u32x2* OIg = (const u32x2*)((unsigned char*)p.out + OUT_OI);
    const size_t rowo = ((size_t)b * SEQ + 64 * j + 16 * tb + fr) * 1024 + h * 128;
    bf16x8 qf[4];
#pragma unroll
    for (int ks = 0; ks < 4; ++ks) qf[ks] = *(const bf16x8*)(QEg + rowo + 32 * ks + 8 * fq);
    u32x2 sg[8];
#pragma unroll
    for (int vb = 0; vb < 8; ++vb) sg[vb] = *(const u32x2*)(SG + rowo + 16 * vb + 4 * fq);
    f32x4 o[8]; float ss = 0.f;
#pragma unroll
    for (int hf = 0; hf < 2; ++hf) {
        bf16x8 sf[4][4]; u32x2 oi[4];
#pragma unroll
        for (int v4 = 0; v4 < 4; ++v4) {
            oi[v4] = OIg[((size_t)(it * 8 + 2 * tb + hf) * 4 + v4) * 64 + lane];
#pragma unroll
            for (int ks = 0; ks < 4; ++ks) { const u32x4 t = SSC[((size_t)(it * 8 + 2 * ks + hf) * 4 + v4) * 64 + lane]; sf[v4][ks] = __builtin_bit_cast(bf16x8, t); }
        }
#pragma unroll
        for (int v4 = 0; v4 < 4; ++v4) { f32x4 a = (f32x4){bflo(oi[v4].x), bfhi(oi[v4].x), bflo(oi[v4].y), bfhi(oi[v4].y)};
#pragma unroll
            for (int ks = 0; ks < 4; ++ks) a = MFMA16(sf[v4][ks], qf[ks], a);
            o[4 * hf + v4] = a; ss += (a[0] * a[0] + a[1] * a[1]) + (a[2] * a[2] + a[3] * a[3]); }
    }
    ss += __shfl_xor(ss, 16); ss += __shfl_xor(ss, 32);
    const float rn = rsqrtf(ss * (1.f / 128.f) + EPS);
#pragma unroll
    for (int vb = 0; vb < 8; ++vb) {
        const f32x4 gn = *(const f32x4*)(p.in[6] + h * 128 + 16 * vb + 4 * fq); const u32x2 g = sg[vb];
        u32x2 y; y.x = pk2(o[vb][0] * rn * gn[0] * silu(bflo(g.x)), o[vb][1] * rn * gn[1] * silu(bfhi(g.x))); y.y = pk2(o[vb][2] * rn * gn[2] * silu(bflo(g.y)), o[vb][3] * rn * gn[3] * silu(bfhi(g.y)));
        *(u32x2*)(YA + rowo + 16 * vb + 4 * fq) = y;
    }
}

DI void norm_rows_to_lds(u32x4 r, const float* g8, float mul, LAS bf16_t* dst) {
    float v[8] = {bflo(r.x), bfhi(r.x), bflo(r.y), bfhi(r.y), bflo(r.z), bfhi(r.z), bflo(r.w), bfhi(r.w)};
    float s = 0.f;
#pragma unroll
    for (int i = 0; i < 8; ++i) s += v[i] * v[i];
    s += __shfl_xor(s, 1); s += __shfl_xor(s, 2); s += __shfl_xor(s, 4); s += __shfl_xor(s, 8);
    const float rs = rsqrtf(s * (1.f / 128.f) + EPS) * mul;
    u32x4 o; o.x = pk2(v[0] * rs * g8[0], v[1] * rs * g8[1]); o.y = pk2(v[2] * rs * g8[2], v[3] * rs * g8[3]); o.z = pk2(v[4] * rs * g8[4], v[5] * rs * g8[5]); o.w = pk2(v[6] * rs * g8[6], v[7] * rs * g8[7]);
    *(LAS u32x4*)dst = o;
}
DI void vt_to_lds(u32x4 r0, u32x4 r1, LAS bf16_t* VTb, int vg, int sp) {
    const unsigned a[4] = {r0.x, r0.y, r0.z, r0.w}, c[4] = {r1.x, r1.y, r1.z, r1.w};
#pragma unroll
    for (int i = 0; i < 4; ++i) {
        *(LAS unsigned*)(VTb + (8 * vg + 2 * i) * 72 + 2 * sp) = (a[i] & 0xffffu) | (c[i] << 16);
        *(LAS unsigned*)(VTb + (8 * vg + 2 * i + 1) * 72 + 2 * sp) = (a[i] >> 16) | (c[i] & 0xffff0000u);
    }
}
struct KvRegs { u32x4 k0, k1, v0, v1; };
DI void kv_load(KvRegs& r, const bf16_t* KBp, const bf16_t* VBp, size_t kt, int h, int srow, int spc, int sp, int vg) {
    r.k0 = *(const u32x4*)(KBp + (kt + srow) * 1024 + h * 128 + 8 * spc); r.k1 = *(const u32x4*)(KBp + (kt + srow + 32) * 1024 + h * 128 + 8 * spc);
    r.v0 = *(const u32x4*)(VBp + (kt + 2 * sp) * 1024 + h * 128 + 8 * vg); r.v1 = *(const u32x4*)(VBp + (kt + 2 * sp + 1) * 1024 + h * 128 + 8 * vg);
}
DI void kv_store(const KvRegs& r, LAS bf16_t* KLn, LAS bf16_t* VTn, const float* kg, int srow, int spc, int sp, int vg) {
    norm_rows_to_lds(r.k0, kg, 1.f, KLn + srow * 136 + 8 * spc); norm_rows_to_lds(r.k1, kg, 1.f, KLn + (srow + 32) * 136 + 8 * spc);
    vt_to_lds(r.v0, r.v1, VTn, vg, sp);
}
DI void attn_item(LAS unsigned char* L, const Params& p, int it) {
    const int tid = threadIdx.x, lane = tid & 63, w = __builtin_amdgcn_readfirstlane(tid >> 6), fr = lane & 15, fq = lane >> 4;
    const int mI = it >> 5, bh = it & 31, b = bh >> 3, h = bh & 7, n0 = 2 * mI, nq = n0 + (w >> 2);
    unsigned char* ws = p.ws;
    const bf16_t* QBp = (const bf16_t*)(ws + WS_QB); const bf16_t* KBp = (const bf16_t*)(ws + WS_KB); const bf16_t* VBp = (const bf16_t*)(ws + WS_VB); bf16_t* YB = (bf16_t*)(ws + WS_YB);
    LAS bf16_t* QL = (LAS bf16_t*)(L + 0);
    LAS bf16_t* KL0 = (LAS bf16_t*)(L + 34816);
    LAS bf16_t* VTL0 = (LAS bf16_t*)(L + 69632);
    LAS float* BIAS = (LAS float*)(L + 106496);
    const size_t tok0 = (size_t)b * SEQ + 64 * n0; const int c0 = n0 > 8 ? n0 - 8 : 0, nch = n0 + 2 - c0;
    const int srow = tid >> 4, spc = tid & 15, sp = tid & 31, vg = tid >> 5;
    if (tid < 191) BIAS[tid] = p.in[9][h * 191 + tid];
    float kg[8];
#pragma unroll
    for (int i = 0; i < 8; ++i) kg[i] = p.in[8][8 * spc + i];
    KvRegs RA, RB;
    {
        const size_t kt0 = (size_t)b * SEQ + 64 * c0;
        KvRegs R0; kv_load(R0, KBp, VBp, kt0, h, srow, spc, sp, vg);
        kv_load(RB, KBp, VBp, kt0 + 64, h, srow, spc, sp, vg);
        float qg[8];
#pragma unroll
        for (int i = 0; i < 8; ++i) qg[i] = p.in[7][8 * spc + i];
#pragma unroll
        for (int ps = 0; ps < 4; ++ps) { const int row = srow + 32 * ps;
            norm_rows_to_lds(*(const u32x4*)(QBp + (tok0 + row) * 1024 + h * 128 + 8 * spc), qg, 0.08838834764831845f, QL + row * 136 + 8 * spc); }
        kv_store(R0, KL0, VTL0, kg, srow, spc, sp, vg);
    }
    __syncthreads();
    bf16x8 qf[4];
#pragma unroll
    for (int ks = 0; ks < 4; ++ks) qf[ks] = ldfrag(QL, 136, 16 * w + fr, 32 * ks + 8 * fq);
    float mrow = -1e30f, lrow = 0.f;
    f32x4 O[8];
#pragma unroll
    for (int i = 0; i < 8; ++i) O[i] = (f32x4){0.f, 0.f, 0.f, 0.f};
    const int qpos = 64 * nq + 16 * (w & 3) + fr;
#define ATT_ITER(i_, LD, ST) do { const int i = (i_); const int c = c0 + i, buf = i & 1; \
        if (i + 2 < nch) kv_load(LD, KBp, VBp, (size_t)b * SEQ + 64 * (c + 2), h, srow, spc, sp, vg); \
        if (c <= nq && c + 8 >= nq) { \
            const LAS bf16_t* KLb = KL0 + buf * 8704; const LAS bf16_t* VTb = VTL0 + buf * 9216; \
            f32x4 s[4]; \
            _Pragma("unroll") for (int kb = 0; kb < 4; ++kb) { s[kb] = (f32x4){0.f, 0.f, 0.f, 0.f}; \
                _Pragma("unroll") for (int ks = 0; ks < 4; ++ks) s[kb] = MFMA16(ldfrag(KLb, 136, 16 * kb + fr, 32 * ks + 8 * fq), qf[ks], s[kb]); } \
            const int d0 = qpos - (64 * c + 4 * fq); float mx = -1e30f; \
            _Pragma("unroll") for (int kb = 0; kb < 4; ++kb) _Pragma("unroll") for (int jj = 0; jj < 4; ++jj) { int d = d0 - 16 * kb - jj; d = d > 127 ? 127 : d; s[kb][jj] += BIAS[d + 63]; mx = fmaxf(mx, s[kb][jj]); } \
            mx = fmaxf(mx, __shfl_xor(mx, 16)); mx = fmaxf(mx, __shfl_xor(mx, 32)); \
            const float mn = fmaxf(mrow, mx), alpha = __expf(mrow - mn); mrow = mn; float ps = 0.f; \
            _Pragma("unroll") for (int kb = 0; kb < 4; ++kb) _Pragma("unroll") for (int jj = 0; jj < 4; ++jj) { s[kb][jj] = __expf(s[kb][jj] - mn); ps += s[kb][jj]; } \
            lrow = lrow * alpha + ps; \
            const u32x4 pw0 = pack8(s[0], s[1]), pw1 = pack8(s[2], s[3]); const bf16x8 pf0 = __builtin_bit_cast(bf16x8, pw0), pf1 = __builtin_bit_cast(bf16x8, pw1); \
            _Pragma("unroll") for (int vb = 0; vb < 8; ++vb) { O[vb] *= alpha; const LAS bf16_t* vr = VTb + (16 * vb + fr) * 72 + 4 * fq; \
                const u32x2 a0 = *(const LAS u32x2*)(vr), a1 = *(const LAS u32x2*)(vr + 16), a2 = *(const LAS u32x2*)(vr + 32), a3 = *(const LAS u32x2*)(vr + 48); \
                const u32x4 v0 = (u32x4){a0.x, a0.y, a1.x, a1.y}, v1 = (u32x4){a2.x, a2.y, a3.x, a3.y}; \
                O[vb] = MFMA16(__builtin_bit_cast(bf16x8, v0), pf0, O[vb]); O[vb] = MFMA16(__builtin_bit_cast(bf16x8, v1), pf1, O[vb]); } \
        } \
        if (i + 1 < nch) kv_store(ST, KL0 + (buf ^ 1) * 8704, VTL0 + (buf ^ 1) * 9216, kg, srow, spc, sp, vg); \
        lds_barrier(); } while (0)
    for (int ii = 0; ii < nch; ii += 2) { ATT_ITER(ii, RA, RB); if (ii + 1 < nch) ATT_ITER(ii + 1, RB, RA); }
#undef ATT_ITER
    lrow += __shfl_xor(lrow, 16); lrow += __shfl_xor(lrow, 32);
    {
        const float inv = 1.f / lrow;
        const size_t o0 = (tok0 + 16 * w + fr) * 1024 + h * 128 + 4 * fq;
#pragma unroll
        for (int vb = 0; vb < 8; ++vb) { u32x2 y; y.x = pk2(O[vb][0] * inv, O[vb][1] * inv); y.y = pk2(O[vb][2] * inv, O[vb][3] * inv); *(u32x2*)(YB + o0 + 16 * vb) = y; }
    }
}

__global__ void __launch_bounds__(512, 2) fwd_kernel(Params p) {
    extern __shared__ __attribute__((aligned(16))) unsigned char lds_raw[];
    LAS unsigned char* L = (LAS unsigned char*)lds_raw;
    cg::grid_group grid = cg::this_grid();
    __shared__ __attribute__((aligned(16))) unsigned xb_st[4];
    if (threadIdx.x < 4) xb_st[threadIdx.x] = 0u;
    __syncthreads();
    const XcdBarrier xbar = xcd_barrier_post((unsigned*)(p.ws + WS_BAR), (volatile LAS unsigned*)xb_st);
    if (p.ph_hi > 64) grid.sync();
    const int G = gridDim.x, lo = p.ph_lo, hi = p.ph_hi;
    unsigned char* ws = p.ws;
#define IN(k) (lo <= (k) && (k) < hi)
#define GSYNC() xcd_barrier(xbar)
#define SEAM(k) do { if ((k) + 1 < hi) GSYNC(); } while (0)
#define NREP(k) ((PROBE_DUP == (k)) ? 2 : 1)
    const int p1rem = ((MTOK / 256) * (NIN / 256)) % G;
    const bool late_in_p1 = (p1rem != 0) && (2 * p1rem <= G) && IN(0) && IN(1);
    const bool late_in_p5 = late_in_p1 && IN(5);
    if (IN(0)) { for (int rep = 0; rep < NREP(0); ++rep) { p0_prologue(L, p, G, late_in_p1 ? I_IN : NITEMS); if (rep + 1 < NREP(0)) GSYNC(); } SEAM(0); }
    if (IN(1)) {
        pg8::SchedPlain S{(const char*)p.out, (const char*)(ws + WS_WIN), MTOK / 256, NIN / 256, DM, G, (int)blockIdx.x, WGM_P1};
        Epi1 E{(bf16_t*)(ws + WS_QS), (bf16_t*)(ws + WS_KK), (bf16_t*)(ws + WS_VI), (bf16_t*)(ws + WS_SG), (bf16_t*)(ws + WS_QB), (bf16_t*)(ws + WS_KB), (bf16_t*)(ws + WS_VB),
               (bf16_t*)(ws + WS_GA), (bf16_t*)(ws + WS_GB), (float*)(ws + WS_LOGF), p.in[5], p.in[2]};
        for (int rep = 0; rep < NREP(1); ++rep) { pg8::gemm_phase(L, DM, S, E); if (rep + 1 < NREP(1)) GSYNC(); }
        if (late_in_p1 && (int)blockIdx.x >= p1rem) convert_items(L, p, I_IN, late_in_p5 ? NITEMS - I_F2 : NITEMS, ((int)blockIdx.x - p1rem) * 8 + (int)(threadIdx.x >> 6), (G - p1rem) * 8);
        SEAM(1);
    }
    if (IN(2)) {
        {
            LocRegs ra, rb; int it = blockIdx.x;
            if (it < 1024) local_load(ra, p, it, threadIdx.x);
            for (; it < 1024; it += G) { const bool more = it + G < 1024; if (more) local_load(rb, p, it + G, threadIdx.x); hgrn_local(L, p, it, ra); if (more) ra = rb; }
        }
        GSYNC();
        if ((int)blockIdx.x < 32) hgrn_sscan(p, blockIdx.x);
        for (;;) {
            if (threadIdx.x == 0) xb_st[2] = atomicAdd((unsigned*)(ws + WS_QCTR), 1u);
            __syncthreads(); const unsigned it = xb_st[2]; __syncthreads();
            if (it >= 512u) break;
            attn_item(L, p, 511 - (int)it);
        }
        GSYNC();
        for (int bi = blockIdx.x; bi < 512; bi += G) hgrn_ointer(p, bi);
        SEAM(2);
    }
    if (IN(3)) {
        pg8::SchedDual S{(const char*)(ws + WS_YA), (const char*)(ws + WS_WPA), (const char*)(ws + WS_YB), (const char*)(ws + WS_WPB), MTOK / 256, DM / 256, DA, G, (int)blockIdx.x};
        Epi3 E{(const unsigned char*)(ws + WS_GA), (const unsigned char*)(ws + WS_GB), (bf16_t*)(ws + WS_MERGED)};
        for (int rep = 0; rep < NREP(3); ++rep) { pg8::gemm_phase(L, DA, S, E); if (rep + 1 < NREP(3)) GSYNC(); } SEAM(3);
    }
    if (IN(4)) {
        pg8::SchedPlain S{(const char*)(ws + WS_MERGED), (const char*)(ws + WS_WO), MTOK / 256, DM / 256, DM, G, (int)blockIdx.x, 4};
        Epi4 E{p.in[0], p.out, (bf16_t*)(ws + WS_X1B), (float*)(ws + WS_CTL)};
        pg8::gemm_phase(L, DM, S, E); SEAM(4);
    }
    if (IN(5)) {
        pg8::SchedPlain S{(const char*)(ws + WS_X1B), (const char*)(ws + WS_WF1), MTOK / 256, NIN / 256, DM, G, (int)blockIdx.x, WGM_P5};
        Epi5 E{(const float*)(ws + WS_CTL), (bf16_t*)(ws + WS_ACT)};
        for (int rep = 0; rep < NREP(5); ++rep) { pg8::gemm_phase(L, DM, S, E); if (rep + 1 < NREP(5)) GSYNC(); }
        if (late_in_p5 && (int)blockIdx.x >= p1rem) convert_items(L, p, NITEMS - I_F2, NITEMS, ((int)blockIdx.x - p1rem) * 8 + (int)(threadIdx.x >> 6), (G - p1rem) * 8);
        SEAM(5);
    }
    if (IN(6)) {
        pg8::SchedPlain S{(const char*)(ws + WS_ACT), (const char*)(ws + WS_WF2), MTOK / 256, DM / 256, DFF, G, (int)blockIdx.x, 4};
        Epi6 E{(const bf16_t*)(ws + WS_X1B), p.out};
        if (PROBE_DUP == 6) { EpiNull EN{(float*)(ws + WS_CTL) + 16000}; pg8::gemm_phase(L, DFF, S, EN); GSYNC(); }
        pg8::gemm_phase(L, DFF, S, E);
    }
#undef IN
#undef SEAM
}

extern "C" void kernel_launch(void* const* d_in, const int* in_sizes, int n_in, void* d_out, int out_size, void* d_ws, size_t ws_size, hipStream_t stream) {
    static int grid = 0;
    if (grid == 0) {
        if (n_in != 15 || out_size != MTOK * DM || ws_size < WS_END) { fprintf(stderr, "kernel_launch: unexpected shapes (n_in %d out %d ws %zu)\n", n_in, out_size, ws_size); grid = -1; return; }
        int dev = 0, cus = 0, per_cu = 0;
        hipGetDevice(&dev); hipDeviceGetAttribute(&cus, hipDeviceAttributeMultiprocessorCount, dev);
        if (hipFuncSetAttribute((const void*)fwd_kernel, hipFuncAttributeMaxDynamicSharedMemorySize, LDS_BYTES) != hipSuccess) { fprintf(stderr, "kernel_launch: hipFuncSetAttribute failed\n"); grid = -1; return; }
        if (hipOccupancyMaxActiveBlocksPerMultiprocessor(&per_cu, (const void*)fwd_kernel, 512, LDS_BYTES) != hipSuccess || per_cu < 1) { fprintf(stderr, "kernel_launch: occupancy query failed (%d)\n", per_cu); grid = -1; return; }
        grid = cus * per_cu;
    }
    if (grid < 0) return;
    if (hipMemsetAsync(d_ws, 0, 131072, stream) != hipSuccess) { fprintf(stderr, "kernel_launch: memset failed\n"); return; }
    Params p{};
    for (int i = 0; i < 15; ++i) p.in[i] = (const float*)d_in[i];
    p.out = (float*)d_out; p.ws = (unsigned char*)d_ws; p.ph_lo = 0; p.ph_hi = 7;
    void* args[] = {&p};
    hipError_t e = hipLaunchCooperativeKernel((const void*)fwd_kernel, dim3(grid), dim3(512), args, LDS_BYTES, stream);
    if (e != hipSuccess) fprintf(stderr, "cooperative launch failed: %s (grid %d)\n", hipGetErrorString(e), grid);
}
```

```cpp
#include <hip/hip_runtime.h>
#include <hip/hip_cooperative_groups.h>
#include <cstdio>
namespace cg = cooperative_groups;

#define LAS __attribute__((address_space(3)))
#define DI __device__ __forceinline__
typedef unsigned short bf16_t;
typedef short bf16x8 __attribute__((ext_vector_type(8)));
typedef float f32x4 __attribute__((ext_vector_type(4)));
typedef float f32x2 __attribute__((ext_vector_type(2)));
typedef unsigned u32x4 __attribute__((ext_vector_type(4)));
typedef unsigned u32x2 __attribute__((ext_vector_type(2)));
typedef __bf16 bf16x2_t __attribute__((ext_vector_type(2)));

constexpr int MTOK = 8192, DM = 2048, NIN = 11264, DFF = 5632, DA = 1024, SEQ = 2048;
constexpr float EPS = 1e-6f;
constexpr size_t MiB = 1u << 20;
constexpr size_t WS_CTL = 0;
constexpr size_t WS_WIN = 1 * MiB;
constexpr size_t WS_YA = 1 * MiB, WS_YB = 17 * MiB, WS_X1B = 1 * MiB;
constexpr size_t WS_WPA = 45 * MiB, WS_WPB = 49 * MiB, WS_WO = 53 * MiB, WS_WF1 = 61 * MiB, WS_WF2 = 105 * MiB;
constexpr size_t WS_QS = 127 * MiB, WS_KK = 143 * MiB, WS_VI = 159 * MiB, WS_SG = 175 * MiB, WS_LOGF = 191 * MiB;
constexpr size_t WS_QB = 223 * MiB, WS_KB = 239 * MiB, WS_VB = 255 * MiB, WS_GA = 271 * MiB, WS_GB = 303 * MiB, WS_QEG = 335 * MiB, WS_END = 351 * MiB;
constexpr size_t WS_EV = 33 * MiB;
constexpr size_t WS_SSC = 191 * MiB;
constexpr size_t WS_QCTR = 131072 - 256;
constexpr size_t OUT_OI = 0, OUT_U = 32 * MiB;
constexpr size_t WS_MERGED = 127 * MiB;
constexpr size_t WS_ACT = 159 * MiB;
constexpr int LDS_BYTES = 131072;
#define WGM_P1 2
#define WGM_P5 4
#ifndef PROBE_DUP
#define PROBE_DUP -1
#endif


struct Params { const float* in[15]; float* out; unsigned char* ws; int ph_lo, ph_hi; };

DI unsigned pk2(float lo, float hi) { f32x2 v = {lo, hi}; bf16x2_t b = __builtin_convertvector(v, bf16x2_t); return __builtin_bit_cast(unsigned, b); }
typedef _Float16 f16x2_t __attribute__((ext_vector_type(2)));
DI unsigned pkh2(float a, float b) { f16x2_t v = {(_Float16)a, (_Float16)b}; return __builtin_bit_cast(unsigned, v); }
DI float bflo(unsigned u) { return __uint_as_float(u << 16); }
DI float bfhi(unsigned u) { return __uint_as_float(u & 0xffff0000u); }
DI float bf2f(bf16_t b) { return __uint_as_float(((unsigned)b) << 16); }
DI float sigm(float x) { return __builtin_amdgcn_rcpf(1.f + __expf(-x)); }
DI float silu(float x) { return x * sigm(x); }
#define MFMA16(a, b, c) __builtin_amdgcn_mfma_f32_16x16x32_bf16((a), (b), (c), 0, 0, 0)


#define XB_TMO      128
#define XB_XCNT(j)  (256  + 64 * (j))
#define XB_XSUB(j)  (1280 + 64 * (j))
#define XB_XGEN(j)  (2304 + 64 * (j))
#define XB_TOP      3328
#define XB_TOPGEN   3392
#define XCD_BAR_WORDS 3456
#define XB_SPIN_CAP (1u << 18)
DI unsigned xb_ld(unsigned* p)              { return __hip_atomic_load(p, __ATOMIC_RELAXED, __HIP_MEMORY_SCOPE_AGENT); }
DI unsigned xb_add(unsigned* p, unsigned v) { return __hip_atomic_fetch_add(p, v, __ATOMIC_RELAXED, __HIP_MEMORY_SCOPE_AGENT); }
DI unsigned xb_xcc_id() { return (unsigned)__builtin_amdgcn_s_getreg((3 << 11) | 20) & 0xFu; }
#define XB_SPIN(cond, bar) do { unsigned _sp = 0; while (cond) { __builtin_amdgcn_s_sleep(1); \
    if ((++_sp & 255u) == 0u) { if (xb_ld(&(bar)[XB_TMO])) break; if (_sp > XB_SPIN_CAP) { atomicAdd(&(bar)[XB_TMO], 1u); break; } } } } while (0)
struct XcdBarrier { unsigned* bar; unsigned x; volatile LAS unsigned* st; };
DI XcdBarrier xcd_barrier_post(unsigned* bar, volatile LAS unsigned* st) {
    XcdBarrier b; b.bar = bar; b.x = xb_xcc_id(); b.st = st;
    if (threadIdx.x == 0) (void)xb_add(&bar[XB_XCNT(b.x)], 1u);
    return b;
}
DI void xcd_barrier_complete(unsigned* bar, unsigned x, unsigned& nloc, unsigned& nx) {
    const unsigned G = gridDim.x * gridDim.y * gridDim.z;
    unsigned sum, cnt, mine, sp = 0u;
    for (;;) {
        sum = 0u; cnt = 0u; mine = 0u;
#pragma unroll
        for (unsigned j = 0; j < 16; ++j) { const unsigned c = xb_ld(&bar[XB_XCNT(j)]); sum += c; cnt += (c > 0u) ? 1u : 0u; mine = (j == x) ? c : mine; }
        if (sum == G) break;
        __builtin_amdgcn_s_sleep(1);
        if ((++sp & 255u) == 0u) { if (xb_ld(&bar[XB_TMO])) break; if (sp > XB_SPIN_CAP) { atomicAdd(&bar[XB_TMO], 1u); break; } }
    }
    nloc = mine > 0u ? mine : 1u; nx = cnt > 0u ? cnt : 1u;
}
DI void xcd_barrier(const XcdBarrier& b) {
    asm volatile("s_waitcnt vmcnt(0)" ::: "memory");
    __syncthreads();
    if (threadIdx.x == 0) {
        unsigned* bar = b.bar;
        __builtin_amdgcn_s_waitcnt(0);
        unsigned nloc = b.st[0], nx = b.st[1];
        if (nloc == 0u) { xcd_barrier_complete(bar, b.x, nloc, nx); b.st[0] = nloc; b.st[1] = nx; }
        const unsigned old = xb_add(&bar[XB_XSUB(b.x)], 1u);
        const unsigned gen = old / nloc;
        if (old + 1u == (gen + 1u) * nloc) {
            __builtin_amdgcn_fence(__ATOMIC_RELEASE, "agent");
            asm volatile("s_waitcnt vmcnt(0)" ::: "memory");
            const unsigned og = xb_add(&bar[XB_TOP], 1u);
            const unsigned tg = og / nx;
            if (og + 1u == (tg + 1u) * nx) xb_add(&bar[XB_TOPGEN], 1u);
            else XB_SPIN(xb_ld(&bar[XB_TOPGEN]) == tg, bar);
            __builtin_amdgcn_fence(__ATOMIC_ACQUIRE, "agent");
            xb_add(&bar[XB_XGEN(b.x)], 1u);
            asm volatile("s_waitcnt vmcnt(0)" ::: "memory");
        } else {
            XB_SPIN(xb_ld(&bar[XB_XGEN(b.x)]) == gen, bar);
            __builtin_amdgcn_fence(__ATOMIC_ACQUIRE, "agent");
            asm volatile("s_waitcnt vmcnt(0)" ::: "memory");
        }
    }
    __syncthreads();
}
constexpr size_t WS_BAR = 65536;

namespace pg8 {
constexpr int BM = 256, BK = 64, HALF = 128, HTB = HALF * BK * 2, STAGE_BYTES = 8 * HTB;
DI int lds_byte(int r, int c) { const int st = (r >> 4) * 2 + (c >> 5), rr = r & 15, cc = c & 31, ob = rr * 64 + cc * 2; return st * 1024 + (ob ^ (((ob >> 9) & 1) << 5)); }
DI void stage_rc(int b, int& R, int& C) { const int st = b / 1024, sb = b % 1024, swz = sb ^ (((sb >> 9) & 1) << 5); R = (st >> 1) * 16 + swz / 64; C = (st & 1) * 32 + (swz % 64) / 2; }
DI int perm32(int rho) { const int n = rho >> 4, i = rho & 15; return 8 * (i >> 2) + 4 * n + (i & 3); }
struct Unit { const char* A; const char* B; int pm, pn, sub; };
DI void tile_of(int L, int nM, int nN, int WGM, int& pm, int& pn) {
    const int nwg = nM * nN; int wgid = L;
    { const int q = nwg / 8, r = nwg % 8, xcd = wgid % 8, off = wgid / 8; wgid = (xcd < r ? xcd * (q + 1) : r * (q + 1) + (xcd - r) * q) + off; }
    const int nig = WGM * nN, gid = wgid / nig, fm = gid * WGM, gsz = (nM - fm) < WGM ? (nM - fm) : WGM;
    pm = fm + ((wgid % nig) % gsz); pn = (wgid % nig) / gsz;
}
struct SchedPlain {
    const char* A; const char* Bt; int nM, nN, K, G, c, wgm;
    DI bool next(int i, Unit& u) const {
        const long L = (long)i * G + c; if (L >= (long)nM * nN) return false;
        tile_of((int)L, nM, nN, wgm, u.pm, u.pn); u.sub = 0;
        u.A = A + (size_t)u.pm * 256 * K * 2; u.B = Bt + (size_t)u.pn * 256 * K * 2; return true;
    }
};
struct SchedDual {
    const char *A0, *B0, *A1, *B1; int nM, nN, K, G, c;
    DI bool next(int i, Unit& u) const {
        const long L = (long)(i >> 1) * G + c; if (L >= (long)nM * nN) return false;
        tile_of((int)L, nM, nN, 4, u.pm, u.pn); u.sub = i & 1;
        u.A = (u.sub ? A1 : A0) + (size_t)u.pm * 256 * K * 2; u.B = (u.sub ? B1 : B0) + (size_t)u.pn * 256 * K * 2; return true;
    }
};

template <class Epi, class Sched>
DI void gemm_phase(LAS unsigned char* lds, const int K, const Sched& S, const Epi& E) {
    const int tid = threadIdx.x, wid = __builtin_amdgcn_readfirstlane(tid >> 6), lane = tid & 63, wr = wid >> 2, wc = wid & 3, fr = lane & 15, fq = lane >> 4;
    const int nt = K / BK;
    unsigned voffA[2], voffB[2];
#pragma unroll
    for (int i = 0; i < 2; ++i) { int R, C; stage_rc(tid * 16 + i * 8192, R, C); const int Rb = (R & ~31) + perm32(R & 31);
        voffA[i] = (unsigned)(R * K + C) * 2u; voffB[i] = (unsigned)(Rb * K + C) * 2u; }
    const size_t kstep = (size_t)(BK * 2);
    const size_t hstep = (size_t)HALF * K * 2;
    const unsigned ldsw = (unsigned)wid * 1024u;
    const int aoff = lds_byte(wr * 64 + fr, fq * 8), boff = lds_byte(wc * 32 + fr, fq * 8);
#define PG8_SA(b, h) (((b) * 2 + (h)) * HTB)
#define PG8_SB(b, h) ((4 + (b) * 2 + (h)) * HTB)
#define PG8_STAGE(bufoff, gbase, voff) do { _Pragma("unroll") for (int _i = 0; _i < 2; ++_i) \
        __builtin_amdgcn_global_load_lds((const unsigned*)((const char*)(gbase) + (voff)[_i]), (LAS unsigned*)(lds + (bufoff) + ldsw + _i * 8192), 16, 0, 0); } while (0)
#define PG8_LDA(dst, b, h) do { _Pragma("unroll") for (int m = 0; m < 4; ++m) _Pragma("unroll") for (int k = 0; k < 2; ++k) dst[m][k] = *(const LAS bf16x8*)(lds + PG8_SA(b, h) + aoff + m * 2048 + k * 1024); } while (0)
#define PG8_LDB(dst, b, h) do { _Pragma("unroll") for (int n = 0; n < 2; ++n) _Pragma("unroll") for (int k = 0; k < 2; ++k) dst[n][k] = *(const LAS bf16x8*)(lds + PG8_SB(b, h) + boff + n * 2048 + k * 1024); } while (0)
#define PG8_MMA(ai, bj, At, Bt) do { __builtin_amdgcn_s_setprio(1); _Pragma("unroll") for (int m = 0; m < 4; ++m) _Pragma("unroll") for (int n = 0; n < 2; ++n) _Pragma("unroll") for (int k = 0; k < 2; ++k) \
        acc[ai][bj][m][n] = __builtin_amdgcn_mfma_f32_16x16x32_bf16(Bt[n][k], At[m][k], acc[ai][bj][m][n], 0, 0, 0); __builtin_amdgcn_s_setprio(0); } while (0)
#define PG8_WAIT_V(n) asm volatile("s_waitcnt vmcnt(" #n ")" ::: "memory")
#define PG8_WAIT_L(n) asm volatile("s_waitcnt lgkmcnt(" #n ")" ::: "memory")
#define PG8_BAR __builtin_amdgcn_s_barrier()
#define PG8_SCHED __builtin_amdgcn_sched_barrier(0)
    Unit cur, nxt; int ui = 0;
    if (!S.next(0, cur)) return;
    f32x4 acc[2][2][4][2];
#pragma unroll
    for (int a = 0; a < 2; ++a)
#pragma unroll
        for (int b = 0; b < 2; ++b)
#pragma unroll
            for (int m = 0; m < 4; ++m)
#pragma unroll
                for (int n = 0; n < 2; ++n) acc[a][b][m][n] = (f32x4){0.f, 0.f, 0.f, 0.f};
    bf16x8 At[4][2], B0[2][2], B1[2][2];
    const char* cA = cur.A; const char* cB = cur.B;
    PG8_STAGE(PG8_SB(0, 0), cB, voffB); PG8_STAGE(PG8_SA(0, 0), cA, voffA); PG8_STAGE(PG8_SB(0, 1), cB + hstep, voffB); PG8_STAGE(PG8_SA(0, 1), cA + hstep, voffA);
    if (wr == 1) PG8_BAR;
    PG8_WAIT_V(4); PG8_BAR;
    PG8_STAGE(PG8_SB(1, 0), cB + kstep, voffB); PG8_STAGE(PG8_SA(1, 0), cA + kstep, voffA); PG8_STAGE(PG8_SB(1, 1), cB + hstep + kstep, voffB);
    PG8_WAIT_V(6); PG8_BAR;
    for (;;) {
        const bool has_next = S.next(ui + 1, nxt);
        const char* nA = has_next ? nxt.A : cA; const char* nB = has_next ? nxt.B : cB;
        for (int t = 0; t < nt; t += 2) {
            const bool last = (t == nt - 2);
            const char* a1 = cA + (size_t)(t + 1) * kstep;
            const char* a2 = last ? nA : cA + (size_t)(t + 2) * kstep; const char* b2 = last ? nB : cB + (size_t)(t + 2) * kstep;
            const char* a3 = a2 + kstep; const char* b3 = b2 + kstep;
            PG8_LDB(B0, 0, 0); PG8_SCHED; PG8_LDA(At, 0, 0); PG8_STAGE(PG8_SA(1, 1), a1 + hstep, voffA);
            PG8_WAIT_L(8); PG8_BAR; PG8_WAIT_L(0); PG8_MMA(0, 0, At, B0); PG8_BAR; PG8_SCHED;
            PG8_LDB(B1, 0, 1); PG8_STAGE(PG8_SB(0, 0), b2, voffB);
            PG8_BAR; PG8_WAIT_L(0); PG8_MMA(0, 1, At, B1); PG8_BAR;
            PG8_LDA(At, 0, 1); PG8_STAGE(PG8_SA(0, 0), a2, voffA);
            PG8_BAR; PG8_WAIT_L(0); PG8_MMA(1, 0, At, B0); PG8_BAR; PG8_SCHED;
            PG8_STAGE(PG8_SB(0, 1), b2 + hstep, voffB);
            PG8_WAIT_V(6); PG8_BAR; PG8_MMA(1, 1, At, B1); PG8_BAR;
            PG8_LDB(B0, 1, 0); PG8_SCHED; PG8_LDA(At, 1, 0); PG8_STAGE(PG8_SA(0, 1), a2 + hstep, voffA);
            PG8_WAIT_L(8); PG8_BAR; PG8_WAIT_L(0); PG8_MMA(0, 0, At, B0); PG8_BAR; PG8_SCHED;
            PG8_LDB(B1, 1, 1); PG8_STAGE(PG8_SB(1, 0), b3, voffB);
            PG8_BAR; PG8_WAIT_L(0); PG8_MMA(0, 1, At, B1); PG8_BAR;
            PG8_LDA(At, 1, 1); PG8_STAGE(PG8_SA(1, 0), a3, voffA);
            PG8_BAR; PG8_WAIT_L(0); PG8_MMA(1, 0, At, B0); PG8_BAR; PG8_SCHED;
            PG8_STAGE(PG8_SB(1, 1), b3 + hstep, voffB);
            PG8_WAIT_V(6); PG8_BAR; PG8_MMA(1, 1, At, B1); PG8_BAR;
        }
        E(acc, cur, wr, wc, fr, fq);
        if (!has_next) break;
        if (!E.keep(cur))
#pragma unroll
        for (int a = 0; a < 2; ++a)
#pragma unroll
            for (int b = 0; b < 2; ++b)
#pragma unroll
                for (int m = 0; m < 4; ++m)
#pragma unroll
                    for (int n = 0; n < 2; ++n) acc[a][b][m][n] = (f32x4){0.f, 0.f, 0.f, 0.f};
        cur = nxt; cA = nA; cB = nB; ++ui;
    }
    PG8_WAIT_V(0);
    if (wr == 0) PG8_BAR;
    PG8_BAR;
#undef PG8_SA
#undef PG8_SB
#undef PG8_STAGE
#undef PG8_LDA
#undef PG8_LDB
#undef PG8_MMA
#undef PG8_WAIT_V
#undef PG8_WAIT_L
#undef PG8_BAR
#undef PG8_SCHED
}
}
using pg8::Unit;
typedef f32x4 Acc[2][2][4][2];

DI u32x4 pack8(const f32x4& a, const f32x4& b) { u32x4 w; w.x = pk2(a[0], a[1]); w.y = pk2(a[2], a[3]); w.z = pk2(b[0], b[1]); w.w = pk2(b[2], b[3]); return w; }

struct Epi1 {
    DI bool keep(const Unit&) const { return false; }
    bf16_t *QS, *KK, *VI, *SG, *QB, *KB, *VB, *GA, *GB; float* LOGF; const float* lbl; const float* bgate;
    DI void operator()(const Acc& acc, const Unit& u, int wr, int wc, int fr, int fq) const {
        const int colt = u.pn * 256, sec = colt >> 10, row0 = u.pm * 256 + wr * 64 + fr, cw = wc * 32 + 8 * fq;
        if (sec == 1) {
#pragma unroll
            for (int bj = 0; bj < 2; ++bj) {
                const int c = colt - 1024 + bj * 128 + cw;
                const f32x4 l0a = *(const f32x4*)(lbl + c), l0b = *(const f32x4*)(lbl + c + 4), l1a = *(const f32x4*)(lbl + 1024 + c), l1b = *(const f32x4*)(lbl + 1024 + c + 4);
                float lb[8];
#pragma unroll
                for (int j = 0; j < 4; ++j) { lb[j] = sigm(l0a[j] - l1a[j]); lb[4 + j] = sigm(l0b[j] - l1b[j]); }
#pragma unroll
                for (int ai = 0; ai < 2; ++ai)
#pragma unroll
                    for (int m = 0; m < 4; ++m) {
                        const size_t o = (size_t)(row0 + ai * 128 + m * 16) * 1024 + c;
                        f32x4 lf[2];
#pragma unroll
                        for (int n = 0; n < 2; ++n)
#pragma unroll
                            for (int j = 0; j < 4; ++j) {
                                const float z = fmaxf(acc[ai][bj][m][n][j], -30.f), e = __expf(-z), sg = __builtin_amdgcn_rcpf(1.f + e), l = lb[4 * n + j];
                                lf[n][j] = __logf(l + (1.f - l) * sg);
                            }
                        *(u32x4*)((_Float16*)LOGF + o) = (u32x4){pkh2(lf[0][0], lf[0][1]), pkh2(lf[0][2], lf[0][3]), pkh2(lf[1][0], lf[1][1]), pkh2(lf[1][2], lf[1][3])};
                    }
            }
            return;
        }
        if (sec >= 7) {
            unsigned char* dst8 = (unsigned char*)(sec < 9 ? GA : GB); const int coff8 = colt - (sec < 9 ? 7168 : 9216);
#pragma unroll
            for (int bj = 0; bj < 2; ++bj) {
                const int bc = colt - 7168 + bj * 128 + cw; const f32x4 b0 = *(const f32x4*)(bgate + bc), b1 = *(const f32x4*)(bgate + bc + 4);
#pragma unroll
                for (int ai = 0; ai < 2; ++ai)
#pragma unroll
                    for (int m = 0; m < 4; ++m) {
                        unsigned q[8];
#pragma unroll
                        for (int j = 0; j < 4; ++j) { q[j] = (unsigned)(sigm(acc[ai][bj][m][0][j] + b0[j]) * 255.f + 0.5f); q[4 + j] = (unsigned)(sigm(acc[ai][bj][m][1][j] + b1[j]) * 255.f + 0.5f); }
                        u32x2 w; w.x = q[0] | (q[1] << 8) | (q[2] << 16) | (q[3] << 24); w.y = q[4] | (q[5] << 8) | (q[6] << 16) | (q[7] << 24);
                        *(u32x2*)(dst8 + (size_t)(row0 + ai * 128 + m * 16) * 2048 + coff8 + bj * 128 + cw) = w;
                    }
            }
            return;
        }
        bf16_t* dst; int ld = 1024, coff, mode = 0;
        if (sec == 0) { dst = QS; coff = colt; }
        else if (sec == 2) { dst = VI; coff = colt - 2048; }
        else if (sec == 3) { dst = SG; coff = colt - 3072; }
        else if (sec == 4) { dst = QB; coff = colt - 4096; }
        else if (sec == 5) { dst = KB; coff = colt - 5120; }
        else { dst = VB; coff = colt - 6144; }
#pragma unroll
        for (int bj = 0; bj < 2; ++bj) {
            const int c = coff + bj * 128 + cw;
            f32x4 b0 = (f32x4){0.f, 0.f, 0.f, 0.f}, b1 = b0;
            if (mode == 2) { const int bc = colt - 7168 + bj * 128 + cw; b0 = *(const f32x4*)(bgate + bc); b1 = *(const f32x4*)(bgate + bc + 4); }
#pragma unroll
            for (int ai = 0; ai < 2; ++ai)
#pragma unroll
                for (int m = 0; m < 4; ++m) {
                    f32x4 v0 = acc[ai][bj][m][0], v1 = acc[ai][bj][m][1];
                    if (mode == 1) {
#pragma unroll
                        for (int j = 0; j < 4; ++j) { v0[j] = silu(v0[j]); v1[j] = silu(v1[j]); }
                    } else if (mode == 2) {
#pragma unroll
                        for (int j = 0; j < 4; ++j) { v0[j] = sigm(v0[j] + b0[j]); v1[j] = sigm(v1[j] + b1[j]); }
                    }
                    *(u32x4*)(dst + (size_t)(row0 + ai * 128 + m * 16) * ld + c) = pack8(v0, v1);
                }
        }
    }
};
struct Epi3 {
    const unsigned char *GA, *GB; bf16_t* MERGED;
    DI bool keep(const Unit& u) const { return u.sub == 0; }
    DI void operator()(Acc& acc, const Unit& u, int wr, int wc, int fr, int fq) const {
        const int row0 = u.pm * 256 + wr * 64 + fr, c0 = u.pn * 256 + wc * 32 + 8 * fq;
#pragma unroll
        for (int ai = 0; ai < 2; ++ai) {
            u32x2 ga[4][2], gb[4][2];
#pragma unroll
            for (int m = 0; m < 4; ++m)
#pragma unroll
                for (int bj = 0; bj < 2; ++bj) {
                    const size_t o = (size_t)(row0 + ai * 128 + m * 16) * DM + c0 + bj * 128;
                    gb[m][bj] = *(const u32x2*)(GB + o);
                    if (u.sub == 0) ga[m][bj] = __builtin_nontemporal_load((const u32x2*)(GA + o));
                }
#pragma unroll
            for (int m = 0; m < 4; ++m)
#pragma unroll
                for (int bj = 0; bj < 2; ++bj) {
                    const unsigned bw[2] = {gb[m][bj].x, gb[m][bj].y};
                    float fb[8];
#pragma unroll
                    for (int j = 0; j < 8; ++j) fb[j] = fmaxf((float)((bw[j >> 2] >> (8 * (j & 3))) & 0xffu), 0.5f);
                    if (u.sub == 0) {
                        const unsigned aw[2] = {ga[m][bj].x, ga[m][bj].y};
#pragma unroll
                        for (int j = 0; j < 8; ++j) acc[ai][bj][m][j >> 2][j & 3] *= (float)((aw[j >> 2] >> (8 * (j & 3))) & 0xffu) * __builtin_amdgcn_rcpf(fb[j]);
                    } else {
                        const size_t o = (size_t)(row0 + ai * 128 + m * 16) * DM + c0 + bj * 128;
                        f32x4 v0 = acc[ai][bj][m][0], v1 = acc[ai][bj][m][1];
#pragma unroll
                        for (int j = 0; j < 4; ++j) { v0[j] *= fb[j] * (1.f / 255.f); v1[j] *= fb[4 + j] * (1.f / 255.f); }
                        *(u32x4*)(MERGED + o) = pack8(v0, v1);
                    }
                }
        }
    }
};
struct Epi4 {
    DI bool keep(const Unit&) const { return false; }
    const float* x; float* out; bf16_t* X1B; float* rowss;
    DI void operator()(const Acc& acc, const Unit& u, int wr, int wc, int fr, int fq) const {
        const int row0 = u.pm * 256 + wr * 64 + fr, c0 = u.pn * 256 + wc * 32 + 8 * fq;
#pragma unroll
        for (int ai = 0; ai < 2; ++ai)
            {
                constexpr int mp = 0;
                f32x4 x0[4][2], x1[4][2];
#pragma unroll
                for (int mm = 0; mm < 4; ++mm)
#pragma unroll
                    for (int bj = 0; bj < 2; ++bj) {
                        const size_t o = (size_t)(row0 + ai * 128 + (2 * mp + mm) * 16) * DM + c0 + bj * 128;
                        x0[mm][bj] = __builtin_nontemporal_load((const f32x4*)(x + o)); x1[mm][bj] = __builtin_nontemporal_load((const f32x4*)(x + o + 4));
                    }
#pragma unroll
                for (int mm = 0; mm < 4; ++mm) {
                    const int m = 2 * mp + mm, row = row0 + ai * 128 + m * 16; float ss = 0.f;
#pragma unroll
                    for (int bj = 0; bj < 2; ++bj) {
                        const size_t o = (size_t)row * DM + c0 + bj * 128;
                        const f32x4 v0 = acc[ai][bj][m][0] + x0[mm][bj], v1 = acc[ai][bj][m][1] + x1[mm][bj];
                        *(u32x4*)(X1B + o) = pack8(v0, v1);
                        ss += (v0[0] * v0[0] + v0[1] * v0[1]) + (v0[2] * v0[2] + v0[3] * v0[3]) + (v1[0] * v1[0] + v1[1] * v1[1]) + (v1[2] * v1[2] + v1[3] * v1[3]);
                    }
                    ss += __shfl_xor(ss, 16); ss += __shfl_xor(ss, 32);
                    if (fq == 0) atomicAdd(rowss + row, ss);
                }
            }
    }
};
struct Epi5 {
    DI bool keep(const Unit&) const { return false; }
    const float* rowss; bf16_t* ACT;
    DI void operator()(const Acc& acc, const Unit& u, int wr, int wc, int fr, int fq) const {
        const int row0 = u.pm * 256 + wr * 64 + fr, c0 = u.pn * 128 + wc * 32 + 8 * fq;
        float rsv[2][4];
#pragma unroll
        for (int ai = 0; ai < 2; ++ai)
#pragma unroll
            for (int m = 0; m < 4; ++m) rsv[ai][m] = rowss[row0 + ai * 128 + m * 16];
#pragma unroll
        for (int ai = 0; ai < 2; ++ai)
#pragma unroll
            for (int m = 0; m < 4; ++m) {
                const int row = row0 + ai * 128 + m * 16;
                const float rs = rsqrtf(rsv[ai][m] * (1.f / DM) + EPS);
                f32x4 a0, a1;
#pragma unroll
                for (int j = 0; j < 4; ++j) { a0[j] = silu(acc[ai][0][m][0][j] * rs) * (acc[ai][1][m][0][j] * rs); a1[j] = silu(acc[ai][0][m][1][j] * rs) * (acc[ai][1][m][1][j] * rs); }
                *(u32x4*)(ACT + (size_t)row * DFF + c0) = pack8(a0, a1);
            }
    }
};
struct EpiNull {
    DI bool keep(const Unit&) const { return false; } float* sink;
    DI void operator()(const Acc& acc, const Unit& u, int wr, int wc, int fr, int fq) const {
        float t = 0.f;
#pragma unroll
        for (int ai = 0; ai < 2; ++ai)
#pragma unroll
            for (int bj = 0; bj < 2; ++bj)
#pragma unroll
                for (int m = 0; m < 4; ++m)
#pragma unroll
                    for (int n = 0; n < 2; ++n) t += acc[ai][bj][m][n][0] + acc[ai][bj][m][n][1] + acc[ai][bj][m][n][2] + acc[ai][bj][m][n][3];
        if (t == 12345.678f) sink[0] = t;
    }
};
struct Epi6 {
    DI bool keep(const Unit&) const { return false; }
    const bf16_t* X1B; float* out;
    DI void operator()(const Acc& acc, const Unit& u, int wr, int wc, int fr, int fq) const {
        const int row0 = u.pm * 256 + wr * 64 + fr, c0 = u.pn * 256 + wc * 32 + 8 * fq;
#pragma unroll
        for (int ai = 0; ai < 2; ++ai) {
            u32x4 xb[4][2];
#pragma unroll
            for (int m = 0; m < 4; ++m)
#pragma unroll
                for (int bj = 0; bj < 2; ++bj) xb[m][bj] = __builtin_nontemporal_load((const u32x4*)(X1B + (size_t)(row0 + ai * 128 + m * 16) * DM + c0 + bj * 128));
#pragma unroll
            for (int m = 0; m < 4; ++m)
#pragma unroll
                for (int bj = 0; bj < 2; ++bj) {
                    const size_t o = (size_t)(row0 + ai * 128 + m * 16) * DM + c0 + bj * 128; const u32x4 t = xb[m][bj];
                    f32x4 v0 = acc[ai][bj][m][0], v1 = acc[ai][bj][m][1];
                    v0[0] += bflo(t.x); v0[1] += bfhi(t.x); v0[2] += bflo(t.y); v0[3] += bfhi(t.y); v1[0] += bflo(t.z); v1[1] += bfhi(t.z); v1[2] += bflo(t.w); v1[3] += bfhi(t.w);
                    *(f32x4*)(out + o) = v0; *(f32x4*)(out + o + 4) = v1;
                }
        }
    }
};

DI void transpose_item(const float* W, int K, int N, bf16_t* WT, int dst_row0, const float* kscale, LAS float* scr, int k0, int n0, int lane) {
    float rr[32];
#pragma unroll
    for (int i = 0; i < 32; ++i) rr[i] = __builtin_nontemporal_load(&W[(size_t)(k0 + 2 * i + (lane >> 5)) * N + n0 + (lane & 31)]);
#pragma unroll
    for (int i = 0; i < 32; ++i) scr[(2 * i + (lane >> 5)) * 33 + (lane & 31)] = rr[i];
    asm volatile("s_waitcnt lgkmcnt(0)" ::: "memory");
    const int c = lane & 7;
    float sc[8];
#pragma unroll
    for (int i = 0; i < 8; ++i) sc[i] = kscale ? kscale[k0 + 8 * c + i] : 1.f;
#pragma unroll
    for (int j = 0; j < 4; ++j) { const int n = (lane >> 3) + 8 * j; const LAS float* s = scr + (8 * c) * 33 + n;
        u32x4 o; o.x = pk2(s[0 * 33] * sc[0], s[1 * 33] * sc[1]); o.y = pk2(s[2 * 33] * sc[2], s[3 * 33] * sc[3]); o.z = pk2(s[4 * 33] * sc[4], s[5 * 33] * sc[5]); o.w = pk2(s[6 * 33] * sc[6], s[7 * 33] * sc[7]);
        *(u32x4*)(WT + (size_t)(dst_row0 + n) * K + k0 + 8 * c) = o; }
    asm volatile("s_waitcnt lgkmcnt(0)" ::: "memory");
}
constexpr int I_IN = (DM / 64) * (NIN / 32), I_PA = (DA / 64) * (DM / 32), I_O = (DM / 64) * (DM / 32), I_F1 = I_IN, I_F2 = (DFF / 64) * (DM / 32);
constexpr int NITEMS = I_IN + 2 * I_PA + I_O + I_F1 + I_F2;
DI void convert_items(LAS unsigned char* L, const Params& p, int lo, int hi, int gw, int NGW) {
    const int tid = threadIdx.x, lane = tid & 63, wave = __builtin_amdgcn_readfirstlane(tid >> 6);
    LAS float* scr = (LAS float*)(L + wave * 16384);
    unsigned char* ws = p.ws;
    for (int it = lo + gw; it < hi; it += NGW) {
        int r = it;
        if (r < I_IN) { const int nblk = NIN / 32, kb = r / nblk, nb = r % nblk; transpose_item(p.in[1], DM, NIN, (bf16_t*)(ws + WS_WIN), 32 * nb, nullptr, scr, 64 * kb, 32 * nb, lane); continue; } r -= I_IN;
        if (r < I_PA) { const int nblk = DM / 32, kb = r / nblk, nb = r % nblk; transpose_item(p.in[10], DA, DM, (bf16_t*)(ws + WS_WPA), 32 * nb, nullptr, scr, 64 * kb, 32 * nb, lane); continue; } r -= I_PA;
        if (r < I_PA) { const int nblk = DM / 32, kb = r / nblk, nb = r % nblk; transpose_item(p.in[11], DA, DM, (bf16_t*)(ws + WS_WPB), 32 * nb, nullptr, scr, 64 * kb, 32 * nb, lane); continue; } r -= I_PA;
        if (r < I_O) { const int nblk = DM / 32, kb = r / nblk, nb = r % nblk; transpose_item(p.in[12], DM, DM, (bf16_t*)(ws + WS_WO), 32 * nb, nullptr, scr, 64 * kb, 32 * nb, lane); continue; } r -= I_O;
        if (r < I_F1) { const int nblk = NIN / 32, kb = r / nblk, nb = r % nblk; const int n0 = 32 * nb;
            const int nn = n0 < DFF ? n0 : n0 - DFF; const int drow = 256 * (nn >> 7) + (n0 < DFF ? 0 : 128) + (nn & 127);
            transpose_item(p.in[13], DM, NIN, (bf16_t*)(ws + WS_WF1), drow, p.in[4], scr, 64 * kb, n0, lane); continue; } r -= I_F1;
        { const int nblk = DM / 32, kb = r / nblk, nb = r % nblk; transpose_item(p.in[14], DFF, DM, (bf16_t*)(ws + WS_WF2), 32 * nb, nullptr, scr, 64 * kb, 32 * nb, lane); }
    }
}
DI void p0_prologue(LAS unsigned char* L, const Params& p, int G, int items_hi) {
    const int tid = threadIdx.x, lane = tid & 63, wave = __builtin_amdgcn_readfirstlane(tid >> 6);
    const int gw = blockIdx.x * 8 + wave, NGW = G * 8;
    unsigned char* ws = p.ws;
    convert_items(L, p, 0, items_hi, gw, NGW);
    bf16_t* H = (bf16_t*)p.out; const float* x = p.in[0]; const float* gain = p.in[3];
    for (int m = gw; m < MTOK; m += NGW) {
        const f32x4* xr = (const f32x4*)(x + (size_t)m * DM) + lane;
        f32x4 v[8]; float s = 0.f;
#pragma unroll
        for (int j = 0; j < 8; ++j) { v[j] = __builtin_nontemporal_load(xr + 64 * j); s += (v[j][0] * v[j][0] + v[j][1] * v[j][1]) + (v[j][2] * v[j][2] + v[j][3] * v[j][3]); }
#pragma unroll
        for (int o = 1; o < 64; o <<= 1) s += __shfl_xor(s, o);
        const float rstd = rsqrtf(s * (1.f / DM) + EPS);
        u32x2* o8 = (u32x2*)(H + (size_t)m * DM) + lane;
#pragma unroll
        for (int j = 0; j < 8; ++j) { const f32x4 g = *((const f32x4*)gain + lane + 64 * j); u32x2 w; w.x = pk2(v[j][0] * rstd * g[0], v[j][1] * rstd * g[1]); w.y = pk2(v[j][2] * rstd * g[2], v[j][3] * rstd * g[3]); o8[64 * j] = w; }
    }
    float* rowss = (float*)(ws + WS_CTL);
    for (int i = blockIdx.x * 512 + tid; i < MTOK; i += G * 512) rowss[i] = 0.f;
}

DI void lds_barrier() { asm volatile("s_waitcnt lgkmcnt(0)" ::: "memory"); __builtin_amdgcn_s_barrier(); asm volatile("" ::: "memory"); }
DI bf16x8 ldfrag(const LAS bf16_t* base, int stride, int row, int k) { return *(const LAS bf16x8*)(base + row * stride + k); }
struct LocRegs { unsigned lfh[8]; unsigned q[8], v[8]; };
DI void local_load(LocRegs& r, const Params& p, int it, int tid) {
    const int bh = it >> 5, j = it & 31, b = bh >> 3, h = bh & 7, cp = tid & 63, rg = tid >> 6;
    const size_t g = ((size_t)b * SEQ + 64 * j + 8 * rg) * 1024 + h * 128 + 2 * cp;
    const float* LOGF = (const float*)(p.ws + WS_LOGF); const bf16_t* QS = (const bf16_t*)(p.ws + WS_QS); const bf16_t* KKp = (const bf16_t*)(p.ws + WS_KK); const bf16_t* VI = (const bf16_t*)(p.ws + WS_VI);
#pragma unroll
    for (int i = 0; i < 8; ++i) { r.lfh[i] = __builtin_nontemporal_load((const unsigned*)((const _Float16*)LOGF + g + (size_t)i * 1024)); r.q[i] = __builtin_nontemporal_load((const unsigned*)(QS + g + (size_t)i * 1024));
        r.v[i] = __builtin_nontemporal_load((const unsigned*)(VI + g + (size_t)i * 1024)); }
}
DI void hgrn_local(LAS unsigned char* L, const Params& p, int it, const LocRegs& r) {
    const int tid = threadIdx.x, lane = tid & 63, w = __builtin_amdgcn_readfirstlane(tid >> 6), fr = lane & 15, fq = lane >> 4;
    const int bh = it >> 5, j = it & 31, b = bh >> 3, h = bh & 7, cp = lane, rg = w;
    unsigned char* ws = p.ws;
    bf16_t* QEg = (bf16_t*)(ws + WS_QEG); float* EVg = (float*)(ws + WS_EV) + (size_t)it * 256;
    u32x2* OIg = (u32x2*)((unsigned char*)p.out + OUT_OI); u32x4* Ug = (u32x4*)((unsigned char*)p.out + OUT_U);
    LAS bf16_t* QE = (LAS bf16_t*)(L + 0); LAS bf16_t* KE = (LAS bf16_t*)(L + 17408); LAS bf16_t* KET = (LAS bf16_t*)(L + 34816); LAS bf16_t* VT = (LAS bf16_t*)(L + 53248);
    LAS bf16_t* PP = (LAS bf16_t*)(L + 71680); LAS float* TOT = (LAS float*)(L + 115712);
    const int tb = w >> 1, wh = w & 1;
    const size_t tok0 = (size_t)b * SEQ + 64 * j;
    float c0[8], c1[8]; float r0 = 0.f, r1 = 0.f;
    float l0[8], l1[8];
#pragma unroll
    for (int i = 0; i < 8; ++i) { const f16x2_t hv = __builtin_bit_cast(f16x2_t, r.lfh[i]); l0[i] = (float)hv[0]; l1[i] = (float)hv[1]; r0 += l0[i]; r1 += l1[i]; c0[i] = r0; c1[i] = r1; }
    *(LAS f32x2*)(TOT + rg * 128 + 2 * cp) = (f32x2){r0, r1};
    lds_barrier();
    f32x2 pre = (f32x2){0.f, 0.f}, post = pre, off = pre;
#pragma unroll
    for (int g = 0; g < 8; ++g) { const f32x2 t = *(const LAS f32x2*)(TOT + g * 128 + 2 * cp);
        if (g < 4) { pre += t; if (g >= rg) off -= t; } else { post += t; if (g < rg) off += t; } }
    float k0s[8], k1s[8];
#pragma unroll
    for (int i = 0; i < 8; ++i) {
        const float e0 = c0[i] + off[0], e1 = c1[i] + off[1];
        const float qe0 = silu(bflo(r.q[i])) * __expf(fminf(e0, 60.f)), qe1 = silu(bfhi(r.q[i])) * __expf(fminf(e1, 60.f));
        k0s[i] = (1.f - __expf(l0[i])) * __expf(fminf(-e0, 60.f)); k1s[i] = (1.f - __expf(l1[i])) * __expf(fminf(-e1, 60.f));
        *(LAS unsigned*)(QE + (8 * rg + i) * 136 + 2 * cp) = pk2(qe0, qe1); *(LAS unsigned*)(KE + (8 * rg + i) * 136 + 2 * cp) = pk2(k0s[i], k1s[i]);
    }
    *(LAS u32x4*)(KET + (2 * cp) * 72 + 8 * rg) = (u32x4){pk2(k0s[0], k0s[1]), pk2(k0s[2], k0s[3]), pk2(k0s[4], k0s[5]), pk2(k0s[6], k0s[7])};
    *(LAS u32x4*)(KET + (2 * cp + 1) * 72 + 8 * rg) = (u32x4){pk2(k1s[0], k1s[1]), pk2(k1s[2], k1s[3]), pk2(k1s[4], k1s[5]), pk2(k1s[6], k1s[7])};
    *(LAS u32x4*)(VT + (2 * cp) * 72 + 8 * rg) = (u32x4){(r.v[0] & 0xffffu) | (r.v[1] << 16), (r.v[2] & 0xffffu) | (r.v[3] << 16), (r.v[4] & 0xffffu) | (r.v[5] << 16), (r.v[6] & 0xffffu) | (r.v[7] << 16)};
    *(LAS u32x4*)(VT + (2 * cp + 1) * 72 + 8 * rg) = (u32x4){(r.v[0] >> 16) | (r.v[1] & 0xffff0000u), (r.v[2] >> 16) | (r.v[3] & 0xffff0000u), (r.v[4] >> 16) | (r.v[5] & 0xffff0000u), (r.v[6] >> 16) | (r.v[7] & 0xffff0000u)};
    if (rg == 0) { *(f32x2*)(EVg + 2 * cp) = (f32x2){__expf(pre[0]), __expf(pre[1])}; *(f32x2*)(EVg + 128 + 2 * cp) = (f32x2){__expf(post[0]), __expf(post[1])}; }
    lds_barrier();
    {
        const int row = tid >> 3, c8 = (tid & 7) * 16;
        const int ksb = c8 & ~31, q0 = (c8 & 31) >> 3;
        const LAS bf16_t* src = QE + row * 136 + ksb;
        const u32x2 l0 = *(const LAS u32x2*)(src + 4 * q0), h0 = *(const LAS u32x2*)(src + 16 + 4 * q0), l1 = *(const LAS u32x2*)(src + 4 * q0 + 4), h1 = *(const LAS u32x2*)(src + 16 + 4 * q0 + 4);
        bf16_t* g = QEg + (tok0 + row) * 1024 + h * 128 + c8; *(u32x4*)g = (u32x4){l0.x, l0.y, h0.x, h0.y}; *(u32x4*)(g + 8) = (u32x4){l1.x, l1.y, h1.x, h1.y};
    }
    {
        bf16x8 qf[4];
#pragma unroll
        for (int ks = 0; ks < 4; ++ks) qf[ks] = ldfrag(QE, 136, 16 * tb + fr, 32 * ks + 8 * fq);
#pragma unroll
        for (int sbi = 0; sbi < 2; ++sbi) {
            const int sb = 2 * wh + sbi; f32x4 a = (f32x4){0.f, 0.f, 0.f, 0.f};
            if (sb <= tb) {
#pragma unroll
                for (int ks = 0; ks < 4; ++ks) a = MFMA16(ldfrag(KE, 136, 16 * sb + fr, 32 * ks + 8 * fq), qf[ks], a);
                if (sb == tb) {
#pragma unroll
                    for (int jj = 0; jj < 4; ++jj) if (4 * fq + jj > fr) a[jj] = 0.f;
                }
            }
            u32x2 o; o.x = pk2(a[0], a[1]); o.y = pk2(a[2], a[3]); *(LAS u32x2*)(PP + (16 * tb + fr) * 72 + 16 * sb + 4 * fq) = o;
        }
    }
    lds_barrier();
    {
        bf16x8 pf[2];
#pragma unroll
        for (int ks = 0; ks < 2; ++ks) pf[ks] = ldfrag(PP, 72, 16 * tb + fr, 32 * ks + 8 * fq);
#pragma unroll
        for (int i = 0; i < 4; ++i) { const int vb = 4 * wh + i; f32x4 a = (f32x4){0.f, 0.f, 0.f, 0.f};
#pragma unroll
            for (int ks = 0; ks < 2; ++ks) a = MFMA16(ldfrag(VT, 72, 16 * vb + fr, 32 * ks + 8 * fq), pf[ks], a);
            u32x2 ob; ob.x = pk2(a[0], a[1]); ob.y = pk2(a[2], a[3]); OIg[((size_t)(it * 8 + w) * 4 + i) * 64 + lane] = ob; }
        bf16x8 kf[2][2];
#pragma unroll
        for (int kb = 0; kb < 2; ++kb)
#pragma unroll
            for (int ks = 0; ks < 2; ++ks) kf[kb][ks] = ldfrag(KET, 72, 32 * tb + 16 * kb + fr, 32 * ks + 8 * fq);
#pragma unroll
        for (int v4 = 0; v4 < 4; ++v4) { const int vb = 4 * wh + v4; f32x4 a0 = (f32x4){0.f, 0.f, 0.f, 0.f}, a1 = a0;
#pragma unroll
            for (int ks = 0; ks < 2; ++ks) { const bf16x8 vf = ldfrag(VT, 72, 16 * vb + fr, 32 * ks + 8 * fq); a0 = MFMA16(kf[0][ks], vf, a0); a1 = MFMA16(kf[1][ks], vf, a1); }
            Ug[((size_t)(it * 8 + w) * 4 + v4) * 64 + lane] = pack8(a0, a1); }
    }
    lds_barrier();
}

struct SStage { u32x4 U[4]; f32x4 er0, er1, el0, el1; };
DI void sscan_load(SStage& r, const Params& p, int it, int w, int lane) {
    const u32x4* Ug = (const u32x4*)((unsigned char*)p.out + OUT_U); const float* EVg = (const float*)(p.ws + WS_EV) + (size_t)it * 256; const int fq = lane >> 4, k0 = 32 * (w >> 1) + 4 * fq;
#pragma unroll
    for (int v4 = 0; v4 < 4; ++v4) r.U[v4] = __builtin_nontemporal_load(Ug + ((size_t)(it * 8 + w) * 4 + v4) * 64 + lane);
    r.er0 = *(const f32x4*)(EVg + k0); r.er1 = *(const f32x4*)(EVg + k0 + 16); r.el0 = *(const f32x4*)(EVg + 128 + k0); r.el1 = *(const f32x4*)(EVg + 128 + k0 + 16);
}
DI void sscan_step(f32x4 (&S)[4][2], const SStage& r, u32x4* SSC, int it, int w, int lane) {
#pragma unroll
    for (int v4 = 0; v4 < 4; ++v4) {
        S[v4][0] *= r.er0; S[v4][1] *= r.er1;
        SSC[((size_t)(it * 8 + w) * 4 + v4) * 64 + lane] = pack8(S[v4][0], S[v4][1]);
        const u32x4 u = r.U[v4];
        S[v4][0][0] = (S[v4][0][0] + bflo(u.x)) * r.el0[0]; S[v4][0][1] = (S[v4][0][1] + bfhi(u.x)) * r.el0[1]; S[v4][0][2] = (S[v4][0][2] + bflo(u.y)) * r.el0[2]; S[v4][0][3] = (S[v4][0][3] + bfhi(u.y)) * r.el0[3];
        S[v4][1][0] = (S[v4][1][0] + bflo(u.z)) * r.el1[0]; S[v4][1][1] = (S[v4][1][1] + bfhi(u.z)) * r.el1[1]; S[v4][1][2] = (S[v4][1][2] + bflo(u.w)) * r.el1[2]; S[v4][1][3] = (S[v4][1][3] + bfhi(u.w)) * r.el1[3];
    }
}
DI void hgrn_sscan(const Params& p, int bh) {
    const int tid = threadIdx.x, lane = tid & 63, w = __builtin_amdgcn_readfirstlane(tid >> 6);
    u32x4* SSC = (u32x4*)(p.ws + WS_SSC);
    f32x4 S[4][2];
#pragma unroll
    for (int i = 0; i < 4; ++i) { S[i][0] = (f32x4){0.f, 0.f, 0.f, 0.f}; S[i][1] = S[i][0]; }
    SStage r0, r1, r2, r3;
    const int it0 = bh * 32;
    sscan_load(r0, p, it0 + 0, w, lane); sscan_load(r1, p, it0 + 1, w, lane); sscan_load(r2, p, it0 + 2, w, lane); sscan_load(r3, p, it0 + 3, w, lane);
    for (int j = 0; j < 32; j += 4) {
        sscan_step(S, r0, SSC, it0 + j, w, lane);     if (j + 4 < 32) sscan_load(r0, p, it0 + j + 4, w, lane);
        sscan_step(S, r1, SSC, it0 + j + 1, w, lane); if (j + 5 < 32) sscan_load(r1, p, it0 + j + 5, w, lane);
        sscan_step(S, r2, SSC, it0 + j + 2, w, lane); if (j + 6 < 32) sscan_load(r2, p, it0 + j + 6, w, lane);
        sscan_step(S, r3, SSC, it0 + j + 3, w, lane); if (j + 7 < 32) sscan_load(r3, p, it0 + j + 7, w, lane);
    }
}
DI void hgrn_ointer(const Params& p, int bi) {
    const int tid = threadIdx.x, lane = tid & 63, w = __builtin_amdgcn_readfirstlane(tid >> 6), fr = lane & 15, fq = lane >> 4;
    const int it = 2 * bi + (w >> 2), tb = w & 3, bh = it >> 5, j = it & 31, b = bh >> 3, h = bh & 7;
    unsigned char* ws = p.ws;
    const bf16_t* QEg = (const bf16_t*)(ws + WS_QEG); const u32x4* SSC = (const u32x4*)(ws + WS_SSC); const bf16_t* SG = (const bf16_t*)(ws + WS_SG); bf16_t* YA = (bf16_t*)(ws + WS_YA);
    const u32x2* OIg = (const u32x2*)((unsigned char*)p.out + OUT_OI);
    const size_t rowo = ((size_t)b * SEQ + 64 * j + 16 * tb + fr) * 1024 + h * 128;
    bf16x8 qf[4];
#pragma unroll
    for (int ks = 0; ks < 4; ++ks) qf[ks] = __builtin_nontemporal_load((const bf16x8*)(QEg + rowo + 32 * ks + 8 * fq));
    u32x2 sg[8];
#pragma unroll
    for (int vb = 0; vb < 8; ++vb) sg[vb] = __builtin_nontemporal_load((const u32x2*)(SG + rowo + 16 * vb + 4 * fq));
    f32x4 o[8]; float ss = 0.f;
#pragma unroll
    for (int hf = 0; hf < 2; ++hf) {
        bf16x8 sf[4][4]; u32x2 oi[4];
#pragma unroll
        for (int v4 = 0; v4 < 4; ++v4) {
            oi[v4] = __builtin_nontemporal_load(OIg + ((size_t)(it * 8 + 2 * tb + hf) * 4 + v4) * 64 + lane);
#pragma unroll
            for (int ks = 0; ks < 4; ++ks) { const u32x4 t = SSC[((size_t)(it * 8 + 2 * ks + hf) * 4 + v4) * 64 + lane]; sf[v4][ks] = __builtin_bit_cast(bf16x8, t); }
        }
#pragma unroll
        for (int v4 = 0; v4 < 4; ++v4) { f32x4 a = (f32x4){bflo(oi[v4].x), bfhi(oi[v4].x), bflo(oi[v4].y), bfhi(oi[v4].y)};
#pragma unroll
            for (int ks = 0; ks < 4; ++ks) a = MFMA16(sf[v4][ks], qf[ks], a);
            o[4 * hf + v4] = a; ss += (a[0] * a[0] + a[1] * a[1]) + (a[2] * a[2] + a[3] * a[3]); }
    }
    ss += __shfl_xor(ss, 16); ss += __shfl_xor(ss, 32);
    const float rn = rsqrtf(ss * (1.f / 128.f) + EPS);
#pragma unroll
    for (int vb = 0; vb < 8; ++vb) {
        const f32x4 gn = *(const f32x4*)(p.in[6] + h * 128 + 16 * vb + 4 * fq); const u32x2 g = sg[vb];
        u32x2 y; y.x = pk2(o[vb][0] * rn * gn[0] * silu(bflo(g.x)), o[vb][1] * rn * gn[1] * silu(bfhi(g.x))); y.y = pk2(o[vb][2] * rn * gn[2] * silu(bflo(g.y)), o[vb][3] * rn * gn[3] * silu(bfhi(g.y)));
        *(u32x2*)(YA + rowo + 16 * vb + 4 * fq) = y;
    }
}

DI void norm_rows_to_lds(u32x4 r, const float* g8, float mul, LAS bf16_t* dst) {
    float v[8] = {bflo(r.x), bfhi(r.x), bflo(r.y), bfhi(r.y), bflo(r.z), bfhi(r.z), bflo(r.w), bfhi(r.w)};
    float s = 0.f;
#pragma unroll
    for (int i = 0; i < 8; ++i) s += v[i] * v[i];
    s += __shfl_xor(s, 1); s += __shfl_xor(s, 2); s += __shfl_xor(s, 4); s += __shfl_xor(s, 8);
    const float rs = rsqrtf(s * (1.f / 128.f) + EPS) * mul;
    u32x4 o; o.x = pk2(v[0] * rs * g8[0], v[1] * rs * g8[1]); o.y = pk2(v[2] * rs * g8[2], v[3] * rs * g8[3]); o.z = pk2(v[4] * rs * g8[4], v[5] * rs * g8[5]); o.w = pk2(v[6] * rs * g8[6], v[7] * rs * g8[7]);
    *(LAS u32x4*)dst = o;
}
DI void vt_to_lds(u32x4 r0, u32x4 r1, LAS bf16_t* VTb, int vg, int sp) {
    const unsigned a[4] = {r0.x, r0.y, r0.z, r0.w}, c[4] = {r1.x, r1.y, r1.z, r1.w};
#pragma unroll
    for (int i = 0; i < 4; ++i) {
        *(LAS unsigned*)(VTb + (8 * vg + 2 * i) * 72 + 2 * sp) = (a[i] & 0xffffu) | (c[i] << 16);
        *(LAS unsigned*)(VTb + (8 * vg + 2 * i + 1) * 72 + 2 * sp) = (a[i] >> 16) | (c[i] & 0xffff0000u);
    }
}
struct KvRegs { u32x4 k0, k1, v0, v1; };
DI void kv_load(KvRegs& r, const bf16_t* KBp, const bf16_t* VBp, size_t kt, int h, int srow, int spc, int sp, int vg) {
    r.k0 = *(const u32x4*)(KBp + (kt + srow) * 1024 + h * 128 + 8 * spc); r.k1 = *(const u32x4*)(KBp + (kt + srow + 32) * 1024 + h * 128 + 8 * spc);
    r.v0 = *(const u32x4*)(VBp + (kt + 2 * sp) * 1024 + h * 128 + 8 * vg); r.v1 = *(const u32x4*)(VBp + (kt + 2 * sp + 1) * 1024 + h * 128 + 8 * vg);
}
DI void kv_store(const KvRegs& r, LAS bf16_t* KLn, LAS bf16_t* VTn, const float* kg, int srow, int spc, int sp, int vg) {
    norm_rows_to_lds(r.k0, kg, 1.f, KLn + srow * 136 + 8 * spc); norm_rows_to_lds(r.k1, kg, 1.f, KLn + (srow + 32) * 136 + 8 * spc);
    vt_to_lds(r.v0, r.v1, VTn, vg, sp);
}
DI void attn_item(LAS unsigned char* L, const Params& p, int it) {
    const int tid = threadIdx.x, lane = tid & 63, w = __builtin_amdgcn_readfirstlane(tid >> 6), fr = lane & 15, fq = lane >> 4;
    const int mI = it >> 5, bh = it & 31, b = bh >> 3, h = bh & 7, n0 = 2 * mI, nq = n0 + (w >> 2);
    unsigned char* ws = p.ws;
    const bf16_t* QBp = (const bf16_t*)(ws + WS_QB); const bf16_t* KBp = (const bf16_t*)(ws + WS_KB); const bf16_t* VBp = (const bf16_t*)(ws + WS_VB); bf16_t* YB = (bf16_t*)(ws + WS_YB);
    LAS bf16_t* QL = (LAS bf16_t*)(L + 0);
    LAS bf16_t* KL0 = (LAS bf16_t*)(L + 34816);
    LAS bf16_t* VTL0 = (LAS bf16_t*)(L + 69632);
    LAS float* BIAS = (LAS float*)(L + 106496);
    const size_t tok0 = (size_t)b * SEQ + 64 * n0; const int c0 = n0 > 8 ? n0 - 8 : 0, nch = n0 + 2 - c0;
    const int srow = tid >> 4, spc = tid & 15, sp = tid & 31, vg = tid >> 5;
    if (tid < 191) BIAS[tid] = p.in[9][h * 191 + tid];
    float kg[8];
#pragma unroll
    for (int i = 0; i < 8; ++i) kg[i] = p.in[8][8 * spc + i];
    KvRegs RA, RB;
    {
        const size_t kt0 = (size_t)b * SEQ + 64 * c0;
        KvRegs R0; kv_load(R0, KBp, VBp, kt0, h, srow, spc, sp, vg);
        kv_load(RB, KBp, VBp, kt0 + 64, h, srow, spc, sp, vg);
        float qg[8];
#pragma unroll
        for (int i = 0; i < 8; ++i) qg[i] = p.in[7][8 * spc + i];
#pragma unroll
        for (int ps = 0; ps < 4; ++ps) { const int row = srow + 32 * ps;
            norm_rows_to_lds(*(const u32x4*)(QBp + (tok0 + row) * 1024 + h * 128 + 8 * spc), qg, 0.08838834764831845f, QL + row * 136 + 8 * spc); }
        kv_store(R0, KL0, VTL0, kg, srow, spc, sp, vg);
    }
    __syncthreads();
    bf16x8 qf[4];
#pragma unroll
    for (int ks = 0; ks < 4; ++ks) qf[ks] = ldfrag(QL, 136, 16 * w + fr, 32 * ks + 8 * fq);
    float mrow = -1e30f, lrow = 0.f;
    f32x4 O[8];
#pragma unroll
    for (int i = 0; i < 8; ++i) O[i] = (f32x4){0.f, 0.f, 0.f, 0.f};
    const int qpos = 64 * nq + 16 * (w & 3) + fr;
#define ATT_ITER(i_, LD, ST) do { const int i = (i_); const int c = c0 + i, buf = i & 1; \
        if (i + 2 < nch) kv_load(LD, KBp, VBp, (size_t)b * SEQ + 64 * (c + 2), h, srow, spc, sp, vg); \
        if (c <= nq && c + 8 >= nq) { \
            const LAS bf16_t* KLb = KL0 + buf * 8704; const LAS bf16_t* VTb = VTL0 + buf * 9216; \
            f32x4 s[4]; \
            _Pragma("unroll") for (int kb = 0; kb < 4; ++kb) { s[kb] = (f32x4){0.f, 0.f, 0.f, 0.f}; \
                _Pragma("unroll") for (int ks = 0; ks < 4; ++ks) s[kb] = MFMA16(ldfrag(KLb, 136, 16 * kb + fr, 32 * ks + 8 * fq), qf[ks], s[kb]); } \
            const int d0 = qpos - (64 * c + 4 * fq); float mx = -1e30f; \
            _Pragma("unroll") for (int kb = 0; kb < 4; ++kb) _Pragma("unroll") for (int jj = 0; jj < 4; ++jj) { int d = d0 - 16 * kb - jj; d = d > 127 ? 127 : d; s[kb][jj] += BIAS[d + 63]; mx = fmaxf(mx, s[kb][jj]); } \
            mx = fmaxf(mx, __shfl_xor(mx, 16)); mx = fmaxf(mx, __shfl_xor(mx, 32)); \
            const float mn = fmaxf(mrow, mx), alpha = __expf(mrow - mn); mrow = mn; float ps = 0.f; \
            _Pragma("unroll") for (int kb = 0; kb < 4; ++kb) _Pragma("unroll") for (int jj = 0; jj < 4; ++jj) { s[kb][jj] = __expf(s[kb][jj] - mn); ps += s[kb][jj]; } \
            lrow = lrow * alpha + ps; \
            const u32x4 pw0 = pack8(s[0], s[1]), pw1 = pack8(s[2], s[3]); const bf16x8 pf0 = __builtin_bit_cast(bf16x8, pw0), pf1 = __builtin_bit_cast(bf16x8, pw1); \
            _Pragma("unroll") for (int vb = 0; vb < 8; ++vb) { O[vb] *= alpha; const LAS bf16_t* vr = VTb + (16 * vb + fr) * 72 + 4 * fq; \
                const u32x2 a0 = *(const LAS u32x2*)(vr), a1 = *(const LAS u32x2*)(vr + 16), a2 = *(const LAS u32x2*)(vr + 32), a3 = *(const LAS u32x2*)(vr + 48); \
                const u32x4 v0 = (u32x4){a0.x, a0.y, a1.x, a1.y}, v1 = (u32x4){a2.x, a2.y, a3.x, a3.y}; \
                O[vb] = MFMA16(__builtin_bit_cast(bf16x8, v0), pf0, O[vb]); O[vb] = MFMA16(__builtin_bit_cast(bf16x8, v1), pf1, O[vb]); } \
        } \
        if (i + 1 < nch) kv_store(ST, KL0 + (buf ^ 1) * 8704, VTL0 + (buf ^ 1) * 9216, kg, srow, spc, sp, vg); \
        lds_barrier(); } while (0)
    for (int ii = 0; ii < nch; ii += 2) { ATT_ITER(ii, RA, RB); if (ii + 1 < nch) ATT_ITER(ii + 1, RB, RA); }
#undef ATT_ITER
    lrow += __shfl_xor(lrow, 16); lrow += __shfl_xor(lrow, 32);
    {
        const float inv = 1.f / lrow;
        const size_t o0 = (tok0 + 16 * w + fr) * 1024 + h * 128 + 4 * fq;
#pragma unroll
        for (int vb = 0; vb < 8; ++vb) { u32x2 y; y.x = pk2(O[vb][0] * inv, O[vb][1] * inv); y.y = pk2(O[vb][2] * inv, O[vb][3] * inv); *(u32x2*)(YB + o0 + 16 * vb) = y; }
    }
}

__global__ void __launch_bounds__(512, 2) fwd_kernel(Params p) {
    extern __shared__ __attribute__((aligned(16))) unsigned char lds_raw[];
    LAS unsigned char* L = (LAS unsigned char*)lds_raw;
    cg::grid_group grid = cg::this_grid();
    __shared__ __attribute__((aligned(16))) unsigned xb_st[4];
    if (threadIdx.x < 4) xb_st[threadIdx.x] = 0u;
    __syncthreads();
    const XcdBarrier xbar = xcd_barrier_post((unsigned*)(p.ws + WS_BAR), (volatile LAS unsigned*)xb_st);
    if (p.ph_hi > 64) grid.sync();
    const int G = gridDim.x, lo = p.ph_lo, hi = p.ph_hi;
    unsigned char* ws = p.ws;
#define IN(k) (lo <= (k) && (k) < hi)
#define GSYNC() xcd_barrier(xbar)
#define SEAM(k) do { if ((k) + 1 < hi) GSYNC(); } while (0)
#define NREP(k) ((PROBE_DUP == (k)) ? 2 : 1)
    const int p1rem = ((MTOK / 256) * (NIN / 256)) % G;
    const bool late_in_p1 = (p1rem != 0) && (2 * p1rem <= G) && IN(0) && IN(1);
    const bool late_in_p5 = late_in_p1 && IN(5);
    if (IN(0)) { for (int rep = 0; rep < NREP(0); ++rep) { p0_prologue(L, p, G, late_in_p1 ? I_IN : NITEMS); if (rep + 1 < NREP(0)) GSYNC(); } SEAM(0); }
    if (IN(1)) {
        pg8::SchedPlain S{(const char*)p.out, (const char*)(ws + WS_WIN), MTOK / 256, NIN / 256, DM, G, (int)blockIdx.x, WGM_P1};
        Epi1 E{(bf16_t*)(ws + WS_QS), (bf16_t*)(ws + WS_KK), (bf16_t*)(ws + WS_VI), (bf16_t*)(ws + WS_SG), (bf16_t*)(ws + WS_QB), (bf16_t*)(ws + WS_KB), (bf16_t*)(ws + WS_VB),
               (bf16_t*)(ws + WS_GA), (bf16_t*)(ws + WS_GB), (float*)(ws + WS_LOGF), p.in[5], p.in[2]};
        for (int rep = 0; rep < NREP(1); ++rep) { pg8::gemm_phase(L, DM, S, E); if (rep + 1 < NREP(1)) GSYNC(); }
        if (late_in_p1 && (int)blockIdx.x >= p1rem) convert_items(L, p, I_IN, late_in_p5 ? NITEMS - I_F2 : NITEMS, ((int)blockIdx.x - p1rem) * 8 + (int)(threadIdx.x >> 6), (G - p1rem) * 8);
        SEAM(1);
    }
    if (IN(2)) {
        {
            LocRegs ra, rb; int it = blockIdx.x;
            if (it < 1024) local_load(ra, p, it, threadIdx.x);
            for (; it < 1024; it += G) { const bool more = it + G < 1024; if (more) local_load(rb, p, it + G, threadIdx.x); hgrn_local(L, p, it, ra); if (more) ra = rb; }
        }
        GSYNC();
        if ((int)blockIdx.x < 32) hgrn_sscan(p, blockIdx.x);
        for (;;) {
            if (threadIdx.x == 0) xb_st[2] = atomicAdd((unsigned*)(ws + WS_QCTR), 1u);
            __syncthreads(); const unsigned it = xb_st[2]; __syncthreads();
            if (it >= 512u) break;
            attn_item(L, p, 511 - (int)it);
        }
        GSYNC();
        for (int bi = blockIdx.x; bi < 512; bi += G) hgrn_ointer(p, bi);
        SEAM(2);
    }
    if (IN(3)) {
        pg8::SchedDual S{(const char*)(ws + WS_YA), (const char*)(ws + WS_WPA), (const char*)(ws + WS_YB), (const char*)(ws + WS_WPB), MTOK / 256, DM / 256, DA, G, (int)blockIdx.x};
        Epi3 E{(const unsigned char*)(ws + WS_GA), (const unsigned char*)(ws + WS_GB), (bf16_t*)(ws + WS_MERGED)};
        for (int rep = 0; rep < NREP(3); ++rep) { pg8::gemm_phase(L, DA, S, E); if (rep + 1 < NREP(3)) GSYNC(); } SEAM(3);
    }
    if (IN(4)) {
        pg8::SchedPlain S{(const char*)(ws + WS_MERGED), (const char*)(ws + WS_WO), MTOK / 256, DM / 256, DM, G, (int)blockIdx.x, 4};
        Epi4 E{p.in[0], p.out, (bf16_t*)(ws + WS_X1B), (float*)(ws + WS_CTL)};
        pg8::gemm_phase(L, DM, S, E); SEAM(4);
    }
    if (IN(5)) {
        pg8::SchedPlain S{(const char*)(ws + WS_X1B), (const char*)(ws + WS_WF1), MTOK / 256, NIN / 256, DM, G, (int)blockIdx.x, WGM_P5};
        Epi5 E{(const float*)(ws + WS_CTL), (bf16_t*)(ws + WS_ACT)};
        for (int rep = 0; rep < NREP(5); ++rep) { pg8::gemm_phase(L, DM, S, E); if (rep + 1 < NREP(5)) GSYNC(); }
        if (late_in_p5 && (int)blockIdx.x >= p1rem) convert_items(L, p, NITEMS - I_F2, NITEMS, ((int)blockIdx.x - p1rem) * 8 + (int)(threadIdx.x >> 6), (G - p1rem) * 8);
        SEAM(5);
    }
    if (IN(6)) {
        pg8::SchedPlain S{(const char*)(ws + WS_ACT), (const char*)(ws + WS_WF2), MTOK / 256, DM / 256, DFF, G, (int)blockIdx.x, 4};
        Epi6 E{(const bf16_t*)(ws + WS_X1B), p.out};
        if (PROBE_DUP == 6) { EpiNull EN{(float*)(ws + WS_CTL) + 16000}; pg8::gemm_phase(L, DFF, S, EN); GSYNC(); }
        pg8::gemm_phase(L, DFF, S, E);
    }
#undef IN
#undef SEAM
}

extern "C" void kernel_launch(void* const* d_in, const int* in_sizes, int n_in, void* d_out, int out_size, void* d_ws, size_t ws_size, hipStream_t stream) {
    static int grid = 0;
    if (grid == 0) {
        if (n_in != 15 || out_size != MTOK * DM || ws_size < WS_END) { fprintf(stderr, "kernel_launch: unexpected shapes (n_in %d out %d ws %zu)\n", n_in, out_size, ws_size); grid = -1; return; }
        int dev = 0, cus = 0, per_cu = 0;
        hipGetDevice(&dev); hipDeviceGetAttribute(&cus, hipDeviceAttributeMultiprocessorCount, dev);
        if (hipFuncSetAttribute((const void*)fwd_kernel, hipFuncAttributeMaxDynamicSharedMemorySize, LDS_BYTES) != hipSuccess) { fprintf(stderr, "kernel_launch: hipFuncSetAttribute failed\n"); grid = -1; return; }
        if (hipOccupancyMaxActiveBlocksPerMultiprocessor(&per_cu, (const void*)fwd_kernel, 512, LDS_BYTES) != hipSuccess || per_cu < 1) { fprintf(stderr, "kernel_launch: occupancy query failed (%d)\n", per_cu); grid = -1; return; }
        grid = cus * per_cu;
    }
    if (grid < 0) return;
    if (hipMemsetAsync(d_ws, 0, 131072, stream) != hipSuccess) { fprintf(stderr, "kernel_launch: memset failed\n"); return; }
    Params p{};
    for (int i = 0; i < 15; ++i) p.in[i] = (const float*)d_in[i];
    p.out = (float*)d_out; p.ws = (unsigned char*)d_ws; p.ph_lo = 0; p.ph_hi = 7;
    void* args[] = {&p};
    hipError_t e = hipLaunchCooperativeKernel((const void*)fwd_kernel, dim3(grid), dim3(512), args, LDS_BYTES, stream);
    if (e != hipSuccess) fprintf(stderr, "cooperative launch failed: %s (grid %d)\n", hipGetErrorString(e), grid);
}
```

```cpp
#include <hip/hip_runtime.h>
#include <hip/hip_cooperative_groups.h>
#include <cstdio>
namespace cg = cooperative_groups;

#define LAS __attribute__((address_space(3)))
#define DI __device__ __forceinline__
typedef unsigned short bf16_t;
typedef short bf16x8 __attribute__((ext_vector_type(8)));
typedef float f32x4 __attribute__((ext_vector_type(4)));
typedef float f32x2 __attribute__((ext_vector_type(2)));
typedef unsigned u32x4 __attribute__((ext_vector_type(4)));
typedef unsigned u32x2 __attribute__((ext_vector_type(2)));
typedef __bf16 bf16x2_t __attribute__((ext_vector_type(2)));

constexpr int MTOK = 8192, DM = 2048, NIN = 11264, DFF = 5632, DA = 1024, SEQ = 2048;
constexpr float EPS = 1e-6f;
constexpr size_t MiB = 1u << 20;
constexpr size_t WS_CTL = 0;
constexpr size_t WS_WIN = 1 * MiB;
constexpr size_t WS_YA = 1 * MiB, WS_YB = 17 * MiB, WS_X1B = 1 * MiB;
constexpr size_t WS_WPA = 45 * MiB, WS_WPB = 49 * MiB, WS_WO = 53 * MiB, WS_WF1 = 61 * MiB, WS_WF2 = 105 * MiB;
constexpr size_t WS_QS = 127 * MiB, WS_KK = 143 * MiB, WS_VI = 159 * MiB, WS_SG = 175 * MiB, WS_LOGF = 191 * MiB;
constexpr size_t WS_QB = 223 * MiB, WS_KB = 239 * MiB, WS_VB = 255 * MiB, WS_GA = 271 * MiB, WS_GB = 303 * MiB, WS_QEG = 335 * MiB, WS_END = 351 * MiB;
constexpr size_t WS_EV = 33 * MiB;
constexpr size_t WS_SSC = 191 * MiB;
constexpr size_t WS_QCTR = 131072 - 256;
constexpr size_t OUT_OI = 0, OUT_U = 32 * MiB;
constexpr size_t WS_MERGED = 127 * MiB;
constexpr size_t WS_ACT = 159 * MiB;
constexpr int LDS_BYTES = 131072;
#define WGM_P1 2
#define WGM_P5 4
#ifndef PROBE_DUP
#define PROBE_DUP -1
#endif


struct Params { const float* in[15]; float* out; unsigned char* ws; int ph_lo, ph_hi; };

DI unsigned pk2(float lo, float hi) { f32x2 v = {lo, hi}; bf16x2_t b = __builtin_convertvector(v, bf16x2_t); return __builtin_bit_cast(unsigned, b); }
typedef _Float16 f16x2_t __attribute__((ext_vector_type(2)));
DI unsigned pkh2(float a, float b) { f16x2_t v = {(_Float16)a, (_Float16)b}; return __builtin_bit_cast(unsigned, v); }
DI float bflo(unsigned u) { return __uint_as_float(u << 16); }
DI float bfhi(unsigned u) { return __uint_as_float(u & 0xffff0000u); }
DI float bf2f(bf16_t b) { return __uint_as_float(((unsigned)b) << 16); }
DI float sigm(float x) { return __builtin_amdgcn_rcpf(1.f + __expf(-x)); }
DI float silu(float x) { return x * sigm(x); }
#define MFMA16(a, b, c) __builtin_amdgcn_mfma_f32_16x16x32_bf16((a), (b), (c), 0, 0, 0)


#define XB_TMO      128
#define XB_XCNT(j)  (256  + 64 * (j))
#define XB_XSUB(j)  (1280 + 64 * (j))
#define XB_XGEN(j)  (2304 + 64 * (j))
#define XB_TOP      3328
#define XB_TOPGEN   3392
#define XCD_BAR_WORDS 3456
#define XB_SPIN_CAP (1u << 18)
DI unsigned xb_ld(unsigned* p)              { return __hip_atomic_load(p, __ATOMIC_RELAXED, __HIP_MEMORY_SCOPE_AGENT); }
DI unsigned xb_add(unsigned* p, unsigned v) { return __hip_atomic_fetch_add(p, v, __ATOMIC_RELAXED, __HIP_MEMORY_SCOPE_AGENT); }
DI unsigned xb_xcc_id() { return (unsigned)__builtin_amdgcn_s_getreg((3 << 11) | 20) & 0xFu; }
#define XB_SPIN(cond, bar) do { unsigned _sp = 0; while (cond) { __builtin_amdgcn_s_sleep(1); \
    if ((++_sp & 255u) == 0u) { if (xb_ld(&(bar)[XB_TMO])) break; if (_sp > XB_SPIN_CAP) { atomicAdd(&(bar)[XB_TMO], 1u); break; } } } } while (0)
struct XcdBarrier { unsigned* bar; unsigned x; volatile LAS unsigned* st; };
DI XcdBarrier xcd_barrier_post(unsigned* bar, volatile LAS unsigned* st) {
    XcdBarrier b; b.bar = bar; b.x = xb_xcc_id(); b.st = st;
    if (threadIdx.x == 0) (void)xb_add(&bar[XB_XCNT(b.x)], 1u);
    return b;
}
DI void xcd_barrier_complete(unsigned* bar, unsigned x, unsigned& nloc, unsigned& nx) {
    const unsigned G = gridDim.x * gridDim.y * gridDim.z;
    unsigned sum, cnt, mine, sp = 0u;
    for (;;) {
        sum = 0u; cnt = 0u; mine = 0u;
#pragma unroll
        for (unsigned j = 0; j < 16; ++j) { const unsigned c = xb_ld(&bar[XB_XCNT(j)]); sum += c; cnt += (c > 0u) ? 1u : 0u; mine = (j == x) ? c : mine; }
        if (sum == G) break;
        __builtin_amdgcn_s_sleep(1);
        if ((++sp & 255u) == 0u) { if (xb_ld(&bar[XB_TMO])) break; if (sp > XB_SPIN_CAP) { atomicAdd(&bar[XB_TMO], 1u); break; } }
    }
    nloc = mine > 0u ? mine : 1u; nx = cnt > 0u ? cnt : 1u;
}
DI void xcd_barrier(const XcdBarrier& b) {
    asm volatile("s_waitcnt vmcnt(0)" ::: "memory");
    __syncthreads();
    if (threadIdx.x == 0) {
        unsigned* bar = b.bar;
        __builtin_amdgcn_s_waitcnt(0);
        unsigned nloc = b.st[0], nx = b.st[1];
        if (nloc == 0u) { xcd_barrier_complete(bar, b.x, nloc, nx); b.st[0] = nloc; b.st[1] = nx; }
        const unsigned old = xb_add(&bar[XB_XSUB(b.x)], 1u);
        const unsigned gen = old / nloc;
        if (old + 1u == (gen + 1u) * nloc) {
            __builtin_amdgcn_fence(__ATOMIC_RELEASE, "agent");
            asm volatile("s_waitcnt vmcnt(0)" ::: "memory");
            const unsigned og = xb_add(&bar[XB_TOP], 1u);
            const unsigned tg = og / nx;
            if (og + 1u == (tg + 1u) * nx) xb_add(&bar[XB_TOPGEN], 1u);
            else XB_SPIN(xb_ld(&bar[XB_TOPGEN]) == tg, bar);
            __builtin_amdgcn_fence(__ATOMIC_ACQUIRE, "agent");
            xb_add(&bar[XB_XGEN(b.x)], 1u);
            asm volatile("s_waitcnt vmcnt(0)" ::: "memory");
        } else {
            XB_SPIN(xb_ld(&bar[XB_XGEN(b.x)]) == gen, bar);
            __builtin_amdgcn_fence(__ATOMIC_ACQUIRE, "agent");
            asm volatile("s_waitcnt vmcnt(0)" ::: "memory");
        }
    }
    __syncthreads();
}
constexpr size_t WS_BAR = 65536;

namespace pg8 {
constexpr int BM = 256, BK = 64, HALF = 128, HTB = HALF * BK * 2, STAGE_BYTES = 8 * HTB;
DI int lds_byte(int r, int c) { const int st = (r >> 4) * 2 + (c >> 5), rr = r & 15, cc = c & 31, ob = rr * 64 + cc * 2; return st * 1024 + (ob ^ (((ob >> 9) & 1) << 5)); }
DI void stage_rc(int b, int& R, int& C) { const int st = b / 1024, sb = b % 1024, swz = sb ^ (((sb >> 9) & 1) << 5); R = (st >> 1) * 16 + swz / 64; C = (st & 1) * 32 + (swz % 64) / 2; }
DI int perm32(int rho) { const int n = rho >> 4, i = rho & 15; return 8 * (i >> 2) + 4 * n + (i & 3); }
struct Unit { const char* A; const char* B; int pm, pn, sub; };
DI void tile_of(int L, int nM, int nN, int WGM, int& pm, int& pn) {
    const int nwg = nM * nN; int wgid = L;
    { const int q = nwg / 8, r = nwg % 8, xcd = wgid % 8, off = wgid / 8; wgid = (xcd < r ? xcd * (q + 1) : r * (q + 1) + (xcd - r) * q) + off; }
    const int nig = WGM * nN, gid = wgid / nig, fm = gid * WGM, gsz = (nM - fm) < WGM ? (nM - fm) : WGM;
    pm = fm + ((wgid % nig) % gsz); pn = (wgid % nig) / gsz;
}
struct SchedPlain {
    const char* A; const char* Bt; int nM, nN, K, G, c, wgm;
    DI bool next(int i, Unit& u) const {
        const long L = (long)i * G + c; if (L >= (long)nM * nN) return false;
        tile_of((int)L, nM, nN, wgm, u.pm, u.pn); u.sub = 0;
        u.A = A + (size_t)u.pm * 256 * K * 2; u.B = Bt + (size_t)u.pn * 256 * K * 2; return true;
    }
};
struct SchedDual {
    const char *A0, *B0, *A1, *B1; int nM, nN, K, G, c;
    DI bool next(int i, Unit& u) const {
        const long L = (long)(i >> 1) * G + c; if (L >= (long)nM * nN) return false;
        tile_of((int)L, nM, nN, 4, u.pm, u.pn); u.sub = i & 1;
        u.A = (u.sub ? A1 : A0) + (size_t)u.pm * 256 * K * 2; u.B = (u.sub ? B1 : B0) + (size_t)u.pn * 256 * K * 2; return true;
    }
};

template <class Epi, class Sched>
DI void gemm_phase(LAS unsigned char* lds, const int K, const Sched& S, const Epi& E) {
    const int tid = threadIdx.x, wid = __builtin_amdgcn_readfirstlane(tid >> 6), lane = tid & 63, wr = wid >> 2, wc = wid & 3, fr = lane & 15, fq = lane >> 4;
    const int nt = K / BK;
    unsigned voffA[2], voffB[2];
#pragma unroll
    for (int i = 0; i < 2; ++i) { int R, C; stage_rc(tid * 16 + i * 8192, R, C); const int Rb = (R & ~31) + perm32(R & 31);
        voffA[i] = (unsigned)(R * K + C) * 2u; voffB[i] = (unsigned)(Rb * K + C) * 2u; }
    const size_t kstep = (size_t)(BK * 2);
    const size_t hstep = (size_t)HALF * K * 2;
    const unsigned ldsw = (unsigned)wid * 1024u;
    const int aoff = lds_byte(wr * 64 + fr, fq * 8), boff = lds_byte(wc * 32 + fr, fq * 8);
#define PG8_SA(b, h) (((b) * 2 + (h)) * HTB)
#define PG8_SB(b, h) ((4 + (b) * 2 + (h)) * HTB)
#define PG8_STAGE(bufoff, gbase, voff) do { _Pragma("unroll") for (int _i = 0; _i < 2; ++_i) \
        __builtin_amdgcn_global_load_lds((const unsigned*)((const char*)(gbase) + (voff)[_i]), (LAS unsigned*)(lds + (bufoff) + ldsw + _i * 8192), 16, 0, 0); } while (0)
#define PG8_LDA(dst, b, h) do { _Pragma("unroll") for (int m = 0; m < 4; ++m) _Pragma("unroll") for (int k = 0; k < 2; ++k) dst[m][k] = *(const LAS bf16x8*)(lds + PG8_SA(b, h) + aoff + m * 2048 + k * 1024); } while (0)
#define PG8_LDB(dst, b, h) do { _Pragma("unroll") for (int n = 0; n < 2; ++n) _Pragma("unroll") for (int k = 0; k < 2; ++k) dst[n][k] = *(const LAS bf16x8*)(lds + PG8_SB(b, h) + boff + n * 2048 + k * 1024); } while (0)
#define PG8_MMA(ai, bj, At, Bt) do { __builtin_amdgcn_s_setprio(1); _Pragma("unroll") for (int m = 0; m < 4; ++m) _Pragma("unroll") for (int n = 0; n < 2; ++n) _Pragma("unroll") for (int k = 0; k < 2; ++k) \
        acc[ai][bj][m][n] = __builtin_amdgcn_mfma_f32_16x16x32_bf16(Bt[n][k], At[m][k], acc[ai][bj][m][n], 0, 0, 0); __builtin_amdgcn_s_setprio(0); } while (0)
#define PG8_WAIT_V(n) asm volatile("s_waitcnt vmcnt(" #n ")" ::: "memory")
#define PG8_WAIT_L(n) asm volatile("s_waitcnt lgkmcnt(" #n ")" ::: "memory")
#define PG8_BAR __builtin_amdgcn_s_barrier()
#define PG8_SCHED __builtin_amdgcn_sched_barrier(0)
    Unit cur, nxt; int ui = 0;
    if (!S.next(0, cur)) return;
    f32x4 acc[2][2][4][2];
#pragma unroll
    for (int a = 0; a < 2; ++a)
#pragma unroll
        for (int b = 0; b < 2; ++b)
#pragma unroll
            for (int m = 0; m < 4; ++m)
#pragma unroll
                for (int n = 0; n < 2; ++n) acc[a][b][m][n] = (f32x4){0.f, 0.f, 0.f, 0.f};
    bf16x8 At[4][2], B0[2][2], B1[2][2];
    const char* cA = cur.A; const char* cB = cur.B;
    PG8_STAGE(PG8_SB(0, 0), cB, voffB); PG8_STAGE(PG8_SA(0, 0), cA, voffA); PG8_STAGE(PG8_SB(0, 1), cB + hstep, voffB); PG8_STAGE(PG8_SA(0, 1), cA + hstep, voffA);
    if (wr == 1) PG8_BAR;
    PG8_WAIT_V(4); PG8_BAR;
    PG8_STAGE(PG8_SB(1, 0), cB + kstep, voffB); PG8_STAGE(PG8_SA(1, 0), cA + kstep, voffA); PG8_STAGE(PG8_SB(1, 1), cB + hstep + kstep, voffB);
    PG8_WAIT_V(6); PG8_BAR;
    for (;;) {
        const bool has_next = S.next(ui + 1, nxt);
        const char* nA = has_next ? nxt.A : cA; const char* nB = has_next ? nxt.B : cB;
        for (int t = 0; t < nt; t += 2) {
            const bool last = (t == nt - 2);
            const char* a1 = cA + (size_t)(t + 1) * kstep;
            const char* a2 = last ? nA : cA + (size_t)(t + 2) * kstep; const char* b2 = last ? nB : cB + (size_t)(t + 2) * kstep;
            const char* a3 = a2 + kstep; const char* b3 = b2 + kstep;
            PG8_LDB(B0, 0, 0); PG8_SCHED; PG8_LDA(At, 0, 0); PG8_STAGE(PG8_SA(1, 1), a1 + hstep, voffA);
            PG8_WAIT_L(8); PG8_BAR; PG8_WAIT_L(0); PG8_MMA(0, 0, At, B0); PG8_BAR; PG8_SCHED;
            PG8_LDB(B1, 0, 1); PG8_STAGE(PG8_SB(0, 0), b2, voffB);
            PG8_BAR; PG8_WAIT_L(0); PG8_MMA(0, 1, At, B1); PG8_BAR;
            PG8_LDA(At, 0, 1); PG8_STAGE(PG8_SA(0, 0), a2, voffA);
            PG8_BAR; PG8_WAIT_L(0); PG8_MMA(1, 0, At, B0); PG8_BAR; PG8_SCHED;
            PG8_STAGE(PG8_SB(0, 1), b2 + hstep, voffB);
            PG8_WAIT_V(6); PG8_BAR; PG8_MMA(1, 1, At, B1); PG8_BAR;
            PG8_LDB(B0, 1, 0); PG8_SCHED; PG8_LDA(At, 1, 0); PG8_STAGE(PG8_SA(0, 1), a2 + hstep, voffA);
            PG8_WAIT_L(8); PG8_BAR; PG8_WAIT_L(0); PG8_MMA(0, 0, At, B0); PG8_BAR; PG8_SCHED;
            PG8_LDB(B1, 1, 1); PG8_STAGE(PG8_SB(1, 0), b3, voffB);
            PG8_BAR; PG8_WAIT_L(0); PG8_MMA(0, 1, At, B1); PG8_BAR;
            PG8_LDA(At, 1, 1); PG8_STAGE(PG8_SA(1, 0), a3, voffA);
            PG8_BAR; PG8_WAIT_L(0); PG8_MMA(1, 0, At, B0); PG8_BAR; PG8_SCHED;
            PG8_STAGE(PG8_SB(1, 1), b3 + hstep, voffB);
            PG8_WAIT_V(6); PG8_BAR; PG8_MMA(1, 1, At, B1); PG8_BAR;
        }
        E(acc, cur, wr, wc, fr, fq);
        if (!has_next) break;
        if (!E.keep(cur))
#pragma unroll
        for (int a = 0; a < 2; ++a)
#pragma unroll
            for (int b = 0; b < 2; ++b)
#pragma unroll
                for (int m = 0; m < 4; ++m)
#pragma unroll
                    for (int n = 0; n < 2; ++n) acc[a][b][m][n] = (f32x4){0.f, 0.f, 0.f, 0.f};
        cur = nxt; cA = nA; cB = nB; ++ui;
    }
    PG8_WAIT_V(0);
    if (wr == 0) PG8_BAR;
    PG8_BAR;
#undef PG8_SA
#undef PG8_SB
#undef PG8_STAGE
#undef PG8_LDA
#undef PG8_LDB
#undef PG8_MMA
#undef PG8_WAIT_V
#undef PG8_WAIT_L
#undef PG8_BAR
#undef PG8_SCHED
}
}
using pg8::Unit;
typedef f32x4 Acc[2][2][4][2];

DI u32x4 pack8(const f32x4& a, const f32x4& b) { u32x4 w; w.x = pk2(a[0], a[1]); w.y = pk2(a[2], a[3]); w.z = pk2(b[0], b[1]); w.w = pk2(b[2], b[3]); return w; }

struct Epi1 {
    DI bool keep(const Unit&) const { return false; }
    bf16_t *QS, *KK, *VI, *SG, *QB, *KB, *VB, *GA, *GB; float* LOGF; const float* lbl; const float* bgate;
    DI void operator()(const Acc& acc, const Unit& u, int wr, int wc, int fr, int fq) const {
        const int colt = u.pn * 256, sec = colt >> 10, row0 = u.pm * 256 + wr * 64 + fr, cw = wc * 32 + 8 * fq;
        if (sec == 1) {
#pragma unroll
            for (int bj = 0; bj < 2; ++bj) {
                const int c = colt - 1024 + bj * 128 + cw;
                const f32x4 l0a = *(const f32x4*)(lbl + c), l0b = *(const f32x4*)(lbl + c + 4), l1a = *(const f32x4*)(lbl + 1024 + c), l1b = *(const f32x4*)(lbl + 1024 + c + 4);
                float lb[8];
#pragma unroll
                for (int j = 0; j < 4; ++j) { lb[j] = sigm(l0a[j] - l1a[j]); lb[4 + j] = sigm(l0b[j] - l1b[j]); }
#pragma unroll
                for (int ai = 0; ai < 2; ++ai)
#pragma unroll
                    for (int m = 0; m < 4; ++m) {
                        const size_t o = (size_t)(row0 + ai * 128 + m * 16) * 1024 + c;
                        f32x4 lf[2];
#pragma unroll
                        for (int n = 0; n < 2; ++n)
#pragma unroll
                            for (int j = 0; j < 4; ++j) {
                                const float z = fmaxf(acc[ai][bj][m][n][j], -30.f), e = __expf(-z), sg = __builtin_amdgcn_rcpf(1.f + e), l = lb[4 * n + j];
                                lf[n][j] = __logf(l + (1.f - l) * sg);
                            }
                        *(u32x4*)((_Float16*)LOGF + o) = (u32x4){pkh2(lf[0][0], lf[0][1]), pkh2(lf[0][2], lf[0][3]), pkh2(lf[1][0], lf[1][1]), pkh2(lf[1][2], lf[1][3])};
                    }
            }
            return;
        }
        if (sec >= 7) {
            unsigned char* dst8 = (unsigned char*)(sec < 9 ? GA : GB); const int coff8 = colt - (sec < 9 ? 7168 : 9216);
#pragma unroll
            for (int bj = 0; bj < 2; ++bj) {
                const int bc = colt - 7168 + bj * 128 + cw; const f32x4 b0 = *(const f32x4*)(bgate + bc), b1 = *(const f32x4*)(bgate + bc + 4);
#pragma unroll
                for (int ai = 0; ai < 2; ++ai)
#pragma unroll
                    for (int m = 0; m < 4; ++m) {
                        unsigned q[8];
#pragma unroll
                        for (int j = 0; j < 4; ++j) { q[j] = (unsigned)(sigm(acc[ai][bj][m][0][j] + b0[j]) * 255.f + 0.5f); q[4 + j] = (unsigned)(sigm(acc[ai][bj][m][1][j] + b1[j]) * 255.f + 0.5f); }
                        u32x2 w; w.x = q[0] | (q[1] << 8) | (q[2] << 16) | (q[3] << 24); w.y = q[4] | (q[5] << 8) | (q[6] << 16) | (q[7] << 24);
                        *(u32x2*)(dst8 + (size_t)(row0 + ai * 128 + m * 16) * 2048 + coff8 + bj * 128 + cw) = w;
                    }
            }
            return;
        }
        bf16_t* dst; int ld = 1024, coff, mode = 0;
        if (sec == 0) { dst = QS; coff = colt; }
        else if (sec == 2) { dst = VI; coff = colt - 2048; }
        else if (sec == 3) { dst = SG; coff = colt - 3072; }
        else if (sec == 4) { dst = QB; coff = colt - 4096; }
        else if (sec == 5) { dst = KB; coff = colt - 5120; }
        else { dst = VB; coff = colt - 6144; }
#pragma unroll
        for (int bj = 0; bj < 2; ++bj) {
            const int c = coff + bj * 128 + cw;
            f32x4 b0 = (f32x4){0.f, 0.f, 0.f, 0.f}, b1 = b0;
            if (mode == 2) { const int bc = colt - 7168 + bj * 128 + cw; b0 = *(const f32x4*)(bgate + bc); b1 = *(const f32x4*)(bgate + bc + 4); }
#pragma unroll
            for (int ai = 0; ai < 2; ++ai)
#pragma unroll
                for (int m = 0; m < 4; ++m) {
                    f32x4 v0 = acc[ai][bj][m][0], v1 = acc[ai][bj][m][1];
                    if (mode == 1) {
#pragma unroll
                        for (int j = 0; j < 4; ++j) { v0[j] = silu(v0[j]); v1[j] = silu(v1[j]); }
                    } else if (mode == 2) {
#pragma unroll
                        for (int j = 0; j < 4; ++j) { v0[j] = sigm(v0[j] + b0[j]); v1[j] = sigm(v1[j] + b1[j]); }
                    }
                    *(u32x4*)(dst + (size_t)(row0 + ai * 128 + m * 16) * ld + c) = pack8(v0, v1);
                }
        }
    }
};
struct Epi3 {
    const unsigned char *GA, *GB; bf16_t* MERGED;
    DI bool keep(const Unit& u) const { return u.sub == 0; }
    DI void operator()(Acc& acc, const Unit& u, int wr, int wc, int fr, int fq) const {
        const int row0 = u.pm * 256 + wr * 64 + fr, c0 = u.pn * 256 + wc * 32 + 8 * fq;
#pragma unroll
        for (int ai = 0; ai < 2; ++ai) {
            u32x2 ga[4][2], gb[4][2];
#pragma unroll
            for (int m = 0; m < 4; ++m)
#pragma unroll
                for (int bj = 0; bj < 2; ++bj) {
                    const size_t o = (size_t)(row0 + ai * 128 + m * 16) * DM + c0 + bj * 128;
                    gb[m][bj] = *(const u32x2*)(GB + o);
                    if (u.sub == 0) ga[m][bj] = __builtin_nontemporal_load((const u32x2*)(GA + o));
                }
#pragma unroll
            for (int m = 0; m < 4; ++m)
#pragma unroll
                for (int bj = 0; bj < 2; ++bj) {
                    const unsigned bw[2] = {gb[m][bj].x, gb[m][bj].y};
                    float fb[8];
#pragma unroll
                    for (int j = 0; j < 8; ++j) fb[j] = fmaxf((float)((bw[j >> 2] >> (8 * (j & 3))) & 0xffu), 0.5f);
                    if (u.sub == 0) {
                        const unsigned aw[2] = {ga[m][bj].x, ga[m][bj].y};
#pragma unroll
                        for (int j = 0; j < 8; ++j) acc[ai][bj][m][j >> 2][j & 3] *= (float)((aw[j >> 2] >> (8 * (j & 3))) & 0xffu) * __builtin_amdgcn_rcpf(fb[j]);
                    } else {
                        const size_t o = (size_t)(row0 + ai * 128 + m * 16) * DM + c0 + bj * 128;
                        f32x4 v0 = acc[ai][bj][m][0], v1 = acc[ai][bj][m][1];
#pragma unroll
                        for (int j = 0; j < 4; ++j) { v0[j] *= fb[j] * (1.f / 255.f); v1[j] *= fb[4 + j] * (1.f / 255.f); }
                        *(u32x4*)(MERGED + o) = pack8(v0, v1);
                    }
                }
        }
    }
};
struct Epi4 {
    DI bool keep(const Unit&) const { return false; }
    const float* x; float* out; bf16_t* X1B; float* rowss;
    DI void operator()(const Acc& acc, const Unit& u, int wr, int wc, int fr, int fq) const {
        const int row0 = u.pm * 256 + wr * 64 + fr, c0 = u.pn * 256 + wc * 32 + 8 * fq;
#pragma unroll
        for (int ai = 0; ai < 2; ++ai)
            {
                constexpr int mp = 0;
                f32x4 x0[4][2], x1[4][2];
#pragma unroll
                for (int mm = 0; mm < 4; ++mm)
#pragma unroll
                    for (int bj = 0; bj < 2; ++bj) {
                        const size_t o = (size_t)(row0 + ai * 128 + (2 * mp + mm) * 16) * DM + c0 + bj * 128;
                        x0[mm][bj] = __builtin_nontemporal_load((const f32x4*)(x + o)); x1[mm][bj] = __builtin_nontemporal_load((const f32x4*)(x + o + 4));
                    }
#pragma unroll
                for (int mm = 0; mm < 4; ++mm) {
                    const int m = 2 * mp + mm, row = row0 + ai * 128 + m * 16; float ss = 0.f;
#pragma unroll
                    for (int bj = 0; bj < 2; ++bj) {
                        const size_t o = (size_t)row * DM + c0 + bj * 128;
                        const f32x4 v0 = acc[ai][bj][m][0] + x0[mm][bj], v1 = acc[ai][bj][m][1] + x1[mm][bj];
                        *(u32x4*)(X1B + o) = pack8(v0, v1);
                        ss += (v0[0] * v0[0] + v0[1] * v0[1]) + (v0[2] * v0[2] + v0[3] * v0[3]) + (v1[0] * v1[0] + v1[1] * v1[1]) + (v1[2] * v1[2] + v1[3] * v1[3]);
                    }
                    ss += __shfl_xor(ss, 16); ss += __shfl_xor(ss, 32);
                    if (fq == 0) atomicAdd(rowss + row, ss);
                }
            }
    }
};
struct Epi5 {
    DI bool keep(const Unit&) const { return false; }
    const float* rowss; bf16_t* ACT;
    DI void operator()(const Acc& acc, const Unit& u, int wr, int wc, int fr, int fq) const {
        const int row0 = u.pm * 256 + wr * 64 + fr, c0 = u.pn * 128 + wc * 32 + 8 * fq;
        float rsv[2][4];
#pragma unroll
        for (int ai = 0; ai < 2; ++ai)
#pragma unroll
            for (int m = 0; m < 4; ++m) rsv[ai][m] = rowss[row0 + ai * 128 + m * 16];
#pragma unroll
        for (int ai = 0; ai < 2; ++ai)
#pragma unroll
            for (int m = 0; m < 4; ++m) {
                const int row = row0 + ai * 128 + m * 16;
                const float rs = rsqrtf(rsv[ai][m] * (1.f / DM) + EPS);
                f32x4 a0, a1;
#pragma unroll
                for (int j = 0; j < 4; ++j) { a0[j] = silu(acc[ai][0][m][0][j] * rs) * (acc[ai][1][m][0][j] * rs); a1[j] = silu(acc[ai][0][m][1][j] * rs) * (acc[ai][1][m][1][j] * rs); }
                *(u32x4*)(ACT + (size_t)row * DFF + c0) = pack8(a0, a1);
            }
    }
};
struct EpiNull {
    DI bool keep(const Unit&) const { return false; } float* sink;
    DI void operator()(const Acc& acc, const Unit& u, int wr, int wc, int fr, int fq) const {
        float t = 0.f;
#pragma unroll
        for (int ai = 0; ai < 2; ++ai)
#pragma unroll
            for (int bj = 0; bj < 2; ++bj)
#pragma unroll
                for (int m = 0; m < 4; ++m)
#pragma unroll
                    for (int n = 0; n < 2; ++n) t += acc[ai][bj][m][n][0] + acc[ai][bj][m][n][1] + acc[ai][bj][m][n][2] + acc[ai][bj][m][n][3];
        if (t == 12345.678f) sink[0] = t;
    }
};
struct Epi6 {
    DI bool keep(const Unit&) const { return false; }
    const bf16_t* X1B; float* out;
    DI void operator()(const Acc& acc, const Unit& u, int wr, int wc, int fr, int fq) const {
        const int row0 = u.pm * 256 + wr * 64 + fr, c0 = u.pn * 256 + wc * 32 + 8 * fq;
#pragma unroll
        for (int ai = 0; ai < 2; ++ai) {
            u32x4 xb[4][2];
#pragma unroll
            for (int m = 0; m < 4; ++m)
#pragma unroll
                for (int bj = 0; bj < 2; ++bj) xb[m][bj] = __builtin_nontemporal_load((const u32x4*)(X1B + (size_t)(row0 + ai * 128 + m * 16) * DM + c0 + bj * 128));
#pragma unroll
            for (int m = 0; m < 4; ++m)
#pragma unroll
                for (int bj = 0; bj < 2; ++bj) {
                    const size_t o = (size_t)(row0 + ai * 128 + m * 16) * DM + c0 + bj * 128; const u32x4 t = xb[m][bj];
                    f32x4 v0 = acc[ai][bj][m][0], v1 = acc[ai][bj][m][1];
                    v0[0] += bflo(t.x); v0[1] += bfhi(t.x); v0[2] += bflo(t.y); v0[3] += bfhi(t.y); v1[0] += bflo(t.z); v1[1] += bfhi(t.z); v1[2] += bflo(t.w); v1[3] += bfhi(t.w);
                    __builtin_nontemporal_store(v0, (f32x4*)(out + o)); __builtin_nontemporal_store(v1, (f32x4*)(out + o + 4));
                }
        }
    }
};

DI void transpose_item(const float* W, int K, int N, bf16_t* WT, int dst_row0, const float* kscale, LAS float* scr, int k0, int n0, int lane, bool ntst = false) {
    float rr[32];
#pragma unroll
    for (int i = 0; i < 32; ++i) rr[i] = __builtin_nontemporal_load(&W[(size_t)(k0 + 2 * i + (lane >> 5)) * N + n0 + (lane & 31)]);
#pragma unroll
    for (int i = 0; i < 32; ++i) scr[(2 * i + (lane >> 5)) * 33 + (lane & 31)] = rr[i];
    asm volatile("s_waitcnt lgkmcnt(0)" ::: "memory");
    const int c = lane & 7;
    float sc[8];
#pragma unroll
    for (int i = 0; i < 8; ++i) sc[i] = kscale ? kscale[k0 + 8 * c + i] : 1.f;
#pragma unroll
    for (int j = 0; j < 4; ++j) { const int n = (lane >> 3) + 8 * j; const LAS float* s = scr + (8 * c) * 33 + n;
        u32x4 o; o.x = pk2(s[0 * 33] * sc[0], s[1 * 33] * sc[1]); o.y = pk2(s[2 * 33] * sc[2], s[3 * 33] * sc[3]); o.z = pk2(s[4 * 33] * sc[4], s[5 * 33] * sc[5]); o.w = pk2(s[6 * 33] * sc[6], s[7 * 33] * sc[7]);
        if (ntst) __builtin_nontemporal_store(o, (u32x4*)(WT + (size_t)(dst_row0 + n) * K + k0 + 8 * c)); else *(u32x4*)(WT + (size_t)(dst_row0 + n) * K + k0 + 8 * c) = o; }
    asm volatile("s_waitcnt lgkmcnt(0)" ::: "memory");
}
constexpr int I_IN = (DM / 64) * (NIN / 32), I_PA = (DA / 64) * (DM / 32), I_O = (DM / 64) * (DM / 32), I_F1 = I_IN, I_F2 = (DFF / 64) * (DM / 32);
constexpr int NITEMS = I_IN + 2 * I_PA + I_O + I_F1 + I_F2;
DI void convert_items(LAS unsigned char* L, const Params& p, int lo, int hi, int gw, int NGW) {
    const int tid = threadIdx.x, lane = tid & 63, wave = __builtin_amdgcn_readfirstlane(tid >> 6);
    LAS float* scr = (LAS float*)(L + wave * 16384);
    unsigned char* ws = p.ws;
    for (int it = lo + gw; it < hi; it += NGW) {
        int r = it;
        if (r < I_IN) { const int nblk = NIN / 32, kb = r / nblk, nb = r % nblk; transpose_item(p.in[1], DM, NIN, (bf16_t*)(ws + WS_WIN), 32 * nb, nullptr, scr, 64 * kb, 32 * nb, lane); continue; } r -= I_IN;
        if (r < I_PA) { const int nblk = DM / 32, kb = r / nblk, nb = r % nblk; transpose_item(p.in[10], DA, DM, (bf16_t*)(ws + WS_WPA), 32 * nb, nullptr, scr, 64 * kb, 32 * nb, lane, true); continue; } r -= I_PA;
        if (r < I_PA) { const int nblk = DM / 32, kb = r / nblk, nb = r % nblk; transpose_item(p.in[11], DA, DM, (bf16_t*)(ws + WS_WPB), 32 * nb, nullptr, scr, 64 * kb, 32 * nb, lane, true); continue; } r -= I_PA;
        if (r < I_O) { const int nblk = DM / 32, kb = r / nblk, nb = r % nblk; transpose_item(p.in[12], DM, DM, (bf16_t*)(ws + WS_WO), 32 * nb, nullptr, scr, 64 * kb, 32 * nb, lane, true); continue; } r -= I_O;
        if (r < I_F1) { const int nblk = NIN / 32, kb = r / nblk, nb = r % nblk; const int n0 = 32 * nb;
            const int nn = n0 < DFF ? n0 : n0 - DFF; const int drow = 256 * (nn >> 7) + (n0 < DFF ? 0 : 128) + (nn & 127);
            transpose_item(p.in[13], DM, NIN, (bf16_t*)(ws + WS_WF1), drow, p.in[4], scr, 64 * kb, n0, lane, true); continue; } r -= I_F1;
        { const int nblk = DM / 32, kb = r / nblk, nb = r % nblk; transpose_item(p.in[14], DFF, DM, (bf16_t*)(ws + WS_WF2), 32 * nb, nullptr, scr, 64 * kb, 32 * nb, lane); }
    }
}
DI void p0_prologue(LAS unsigned char* L, const Params& p, int G, int items_hi) {
    const int tid = threadIdx.x, lane = tid & 63, wave = __builtin_amdgcn_readfirstlane(tid >> 6);
    const int gw = blockIdx.x * 8 + wave, NGW = G * 8;
    unsigned char* ws = p.ws;
    convert_items(L, p, 0, items_hi, gw, NGW);
    bf16_t* H = (bf16_t*)p.out; const float* x = p.in[0]; const float* gain = p.in[3];
    for (int m = gw; m < MTOK; m += NGW) {
        const f32x4* xr = (const f32x4*)(x + (size_t)m * DM) + lane;
        f32x4 v[8]; float s = 0.f;
#pragma unroll
        for (int j = 0; j < 8; ++j) { v[j] = __builtin_nontemporal_load(xr + 64 * j); s += (v[j][0] * v[j][0] + v[j][1] * v[j][1]) + (v[j][2] * v[j][2] + v[j][3] * v[j][3]); }
#pragma unroll
        for (int o = 1; o < 64; o <<= 1) s += __shfl_xor(s, o);
        const float rstd = rsqrtf(s * (1.f / DM) + EPS);
        u32x2* o8 = (u32x2*)(H + (size_t)m * DM) + lane;
#pragma unroll
        for (int j = 0; j < 8; ++j) { const f32x4 g = *((const f32x4*)gain + lane + 64 * j); u32x2 w; w.x = pk2(v[j][0] * rstd * g[0], v[j][1] * rstd * g[1]); w.y = pk2(v[j][2] * rstd * g[2], v[j][3] * rstd * g[3]); o8[64 * j] = w; }
    }
    float* rowss = (float*)(ws + WS_CTL);
    for (int i = blockIdx.x * 512 + tid; i < MTOK; i += G * 512) rowss[i] = 0.f;
}

DI void lds_barrier() { asm volatile("s_waitcnt lgkmcnt(0)" ::: "memory"); __builtin_amdgcn_s_barrier(); asm volatile("" ::: "memory"); }
DI bf16x8 ldfrag(const LAS bf16_t* base, int stride, int row, int k) { return *(const LAS bf16x8*)(base + row * stride + k); }
struct LocRegs { unsigned lfh[8]; unsigned q[8], v[8]; };
DI void local_load(LocRegs& r, const Params& p, int it, int tid) {
    const int bh = it >> 5, j = it & 31, b = bh >> 3, h = bh & 7, cp = tid & 63, rg = tid >> 6;
    const size_t g = ((size_t)b * SEQ + 64 * j + 8 * rg) * 1024 + h * 128 + 2 * cp;
    const float* LOGF = (const float*)(p.ws + WS_LOGF); const bf16_t* QS = (const bf16_t*)(p.ws + WS_QS); const bf16_t* KKp = (const bf16_t*)(p.ws + WS_KK); const bf16_t* VI = (const bf16_t*)(p.ws + WS_VI);
#pragma unroll
    for (int i = 0; i < 8; ++i) { r.lfh[i] = __builtin_nontemporal_load((const unsigned*)((const _Float16*)LOGF + g + (size_t)i * 1024)); r.q[i] = __builtin_nontemporal_load((const unsigned*)(QS + g + (size_t)i * 1024));
        r.v[i] = __builtin_nontemporal_load((const unsigned*)(VI + g + (size_t)i * 1024)); }
}
DI void hgrn_local(LAS unsigned char* L, const Params& p, int it, const LocRegs& r) {
    const int tid = threadIdx.x, lane = tid & 63, w = __builtin_amdgcn_readfirstlane(tid >> 6), fr = lane & 15, fq = lane >> 4;
    const int bh = it >> 5, j = it & 31, b = bh >> 3, h = bh & 7, cp = lane, rg = w;
    unsigned char* ws = p.ws;
    bf16_t* QEg = (bf16_t*)(ws + WS_QEG); float* EVg = (float*)(ws + WS_EV) + (size_t)it * 256;
    u32x2* OIg = (u32x2*)((unsigned char*)p.out + OUT_OI); u32x4* Ug = (u32x4*)((unsigned char*)p.out + OUT_U);
    LAS bf16_t* QE = (LAS bf16_t*)(L + 0); LAS bf16_t* KE = (LAS bf16_t*)(L + 17408); LAS bf16_t* KET = (LAS bf16_t*)(L + 34816); LAS bf16_t* VT = (LAS bf16_t*)(L + 53248);
    LAS bf16_t* PP = (LAS bf16_t*)(L + 71680); LAS float* TOT = (LAS float*)(L + 115712);
    const int tb = w >> 1, wh = w & 1;
    const size_t tok0 = (size_t)b * SEQ + 64 * j;
    float c0[8], c1[8]; float r0 = 0.f, r1 = 0.f;
    float l0[8], l1[8];
#pragma unroll
    for (int i = 0; i < 8; ++i) { const f16x2_t hv = __builtin_bit_cast(f16x2_t, r.lfh[i]); l0[i] = (float)hv[0]; l1[i] = (float)hv[1]; r0 += l0[i]; r1 += l1[i]; c0[i] = r0; c1[i] = r1; }
    *(LAS f32x2*)(TOT + rg * 128 + 2 * cp) = (f32x2){r0, r1};
    lds_barrier();
    f32x2 pre = (f32x2){0.f, 0.f}, post = pre, off = pre;
#pragma unroll
    for (int g = 0; g < 8; ++g) { const f32x2 t = *(const LAS f32x2*)(TOT + g * 128 + 2 * cp);
        if (g < 4) { pre += t; if (g >= rg) off -= t; } else { post += t; if (g < rg) off += t; } }
    float k0s[8], k1s[8];
#pragma unroll
    for (int i = 0; i < 8; ++i) {
        const float e0 = c0[i] + off[0], e1 = c1[i] + off[1];
        const float qe0 = silu(bflo(r.q[i])) * __expf(fminf(e0, 60.f)), qe1 = silu(bfhi(r.q[i])) * __expf(fminf(e1, 60.f));
        k0s[i] = (1.f - __expf(l0[i])) * __expf(fminf(-e0, 60.f)); k1s[i] = (1.f - __expf(l1[i])) * __expf(fminf(-e1, 60.f));
        *(LAS unsigned*)(QE + (8 * rg + i) * 136 + 2 * cp) = pk2(qe0, qe1); *(LAS unsigned*)(KE + (8 * rg + i) * 136 + 2 * cp) = pk2(k0s[i], k1s[i]);
    }
    *(LAS u32x4*)(KET + (2 * cp) * 72 + 8 * rg) = (u32x4){pk2(k0s[0], k0s[1]), pk2(k0s[2], k0s[3]), pk2(k0s[4], k0s[5]), pk2(k0s[6], k0s[7])};
    *(LAS u32x4*)(KET + (2 * cp + 1) * 72 + 8 * rg) = (u32x4){pk2(k1s[0], k1s[1]), pk2(k1s[2], k1s[3]), pk2(k1s[4], k1s[5]), pk2(k1s[6], k1s[7])};
    *(LAS u32x4*)(VT + (2 * cp) * 72 + 8 * rg) = (u32x4){(r.v[0] & 0xffffu) | (r.v[1] << 16), (r.v[2] & 0xffffu) | (r.v[3] << 16), (r.v[4] & 0xffffu) | (r.v[5] << 16), (r.v[6] & 0xffffu) | (r.v[7] << 16)};
    *(LAS u32x4*)(VT + (2 * cp + 1) * 72 + 8 * rg) = (u32x4){(r.v[0] >> 16) | (r.v[1] & 0xffff0000u), (r.v[2] >> 16) | (r.v[3] & 0xffff0000u), (r.v[4] >> 16) | (r.v[5] & 0xffff0000u), (r.v[6] >> 16) | (r.v[7] & 0xffff0000u)};
    if (rg == 0) { *(f32x2*)(EVg + 2 * cp) = (f32x2){__expf(pre[0]), __expf(pre[1])}; *(f32x2*)(EVg + 128 + 2 * cp) = (f32x2){__expf(post[0]), __expf(post[1])}; }
    lds_barrier();
    {
        const int row = tid >> 3, c8 = (tid & 7) * 16;
        const int ksb = c8 & ~31, q0 = (c8 & 31) >> 3;
        const LAS bf16_t* src = QE + row * 136 + ksb;
        const u32x2 l0 = *(const LAS u32x2*)(src + 4 * q0), h0 = *(const LAS u32x2*)(src + 16 + 4 * q0), l1 = *(const LAS u32x2*)(src + 4 * q0 + 4), h1 = *(const LAS u32x2*)(src + 16 + 4 * q0 + 4);
        bf16_t* g = QEg + (tok0 + row) * 1024 + h * 128 + c8; *(u32x4*)g = (u32x4){l0.x, l0.y, h0.x, h0.y}; *(u32x4*)(g + 8) = (u32x4){l1.x, l1.y, h1.x, h1.y};
    }
    {
        bf16x8 qf[4];
#pragma unroll
        for (int ks = 0; ks < 4; ++ks) qf[ks] = ldfrag(QE, 136, 16 * tb + fr, 32 * ks + 8 * fq);
#pragma unroll
        for (int sbi = 0; sbi < 2; ++sbi) {
            const int sb = 2 * wh + sbi; f32x4 a = (f32x4){0.f, 0.f, 0.f, 0.f};
            if (sb <= tb) {
#pragma unroll
                for (int ks = 0; ks < 4; ++ks) a = MFMA16(ldfrag(KE, 136, 16 * sb + fr, 32 * ks + 8 * fq), qf[ks], a);
                if (sb == tb) {
#pragma unroll
                    for (int jj = 0; jj < 4; ++jj) if (4 * fq + jj > fr) a[jj] = 0.f;
                }
            }
            u32x2 o; o.x = pk2(a[0], a[1]); o.y = pk2(a[2], a[3]); *(LAS u32x2*)(PP + (16 * tb + fr) * 72 + 16 * sb + 4 * fq) = o;
        }
    }
    lds_barrier();
    {
        bf16x8 pf[2];
#pragma unroll
        for (int ks = 0; ks < 2; ++ks) pf[ks] = ldfrag(PP, 72, 16 * tb + fr, 32 * ks + 8 * fq);
#pragma unroll
        for (int i = 0; i < 4; ++i) { const int vb = 4 * wh + i; f32x4 a = (f32x4){0.f, 0.f, 0.f, 0.f};
#pragma unroll
            for (int ks = 0; ks < 2; ++ks) a = MFMA16(ldfrag(VT, 72, 16 * vb + fr, 32 * ks + 8 * fq), pf[ks], a);
            u32x2 ob; ob.x = pk2(a[0], a[1]); ob.y = pk2(a[2], a[3]); OIg[((size_t)(it * 8 + w) * 4 + i) * 64 + lane] = ob; }
        bf16x8 kf[2][2];
#pragma unroll
        for (int kb = 0; kb < 2; ++kb)
#pragma unroll
            for (int ks = 0; ks < 2; ++ks) kf[kb][ks] = ldfrag(KET, 72, 32 * tb + 16 * kb + fr, 32 * ks + 8 * fq);
#pragma unroll
        for (int v4 = 0; v4 < 4; ++v4) { const int vb = 4 * wh + v4; f32x4 a0 = (f32x4){0.f, 0.f, 0.f, 0.f}, a1 = a0;
#pragma unroll
            for (int ks = 0; ks < 2; ++ks) { const bf16x8 vf = ldfrag(VT, 72, 16 * vb + fr, 32 * ks + 8 * fq); a0 = MFMA16(kf[0][ks], vf, a0); a1 = MFMA16(kf[1][ks], vf, a1); }
            Ug[((size_t)(it * 8 + w) * 4 + v4) * 64 + lane] = pack8(a0, a1); }
    }
    lds_barrier();
}

struct SStage { u32x4 U[4]; f32x4 er0, er1, el0, el1; };
DI void sscan_load(SStage& r, const Params& p, int it, int w, int lane) {
    const u32x4* Ug = (const u32x4*)((unsigned char*)p.out + OUT_U); const float* EVg = (const float*)(p.ws + WS_EV) + (size_t)it * 256; const int fq = lane >> 4, k0 = 32 * (w >> 1) + 4 * fq;
#pragma unroll
    for (int v4 = 0; v4 < 4; ++v4) r.U[v4] = __builtin_nontemporal_load(Ug + ((size_t)(it * 8 + w) * 4 + v4) * 64 + lane);
    r.er0 = *(const f32x4*)(EVg + k0); r.er1 = *(const f32x4*)(EVg + k0 + 16); r.el0 = *(const f32x4*)(EVg + 128 + k0); r.el1 = *(const f32x4*)(EVg + 128 + k0 + 16);
}
DI void sscan_step(f32x4 (&S)[4][2], const SStage& r, u32x4* SSC, int it, int w, int lane) {
#pragma unroll
    for (int v4 = 0; v4 < 4; ++v4) {
        S[v4][0] *= r.er0; S[v4][1] *= r.er1;
        SSC[((size_t)(it * 8 + w) * 4 + v4) * 64 + lane] = pack8(S[v4][0], S[v4][1]);
        const u32x4 u = r.U[v4];
        S[v4][0][0] = (S[v4][0][0] + bflo(u.x)) * r.el0[0]; S[v4][0][1] = (S[v4][0][1] + bfhi(u.x)) * r.el0[1]; S[v4][0][2] = (S[v4][0][2] + bflo(u.y)) * r.el0[2]; S[v4][0][3] = (S[v4][0][3] + bfhi(u.y)) * r.el0[3];
        S[v4][1][0] = (S[v4][1][0] + bflo(u.z)) * r.el1[0]; S[v4][1][1] = (S[v4][1][1] + bfhi(u.z)) * r.el1[1]; S[v4][1][2] = (S[v4][1][2] + bflo(u.w)) * r.el1[2]; S[v4][1][3] = (S[v4][1][3] + bfhi(u.w)) * r.el1[3];
    }
}
DI void hgrn_sscan(const Params& p, int bh) {
    const int tid = threadIdx.x, lane = tid & 63, w = __builtin_amdgcn_readfirstlane(tid >> 6);
    u32x4* SSC = (u32x4*)(p.ws + WS_SSC);
    f32x4 S[4][2];
#pragma unroll
    for (int i = 0; i < 4; ++i) { S[i][0] = (f32x4){0.f, 0.f, 0.f, 0.f}; S[i][1] = S[i][0]; }
    SStage r0, r1, r2, r3;
    const int it0 = bh * 32;
    sscan_load(r0, p, it0 + 0, w, lane); sscan_load(r1, p, it0 + 1, w, lane); sscan_load(r2, p, it0 + 2, w, lane); sscan_load(r3, p, it0 + 3, w, lane);
    for (int j = 0; j < 32; j += 4) {
        sscan_step(S, r0, SSC, it0 + j, w, lane);     if (j + 4 < 32) sscan_load(r0, p, it0 + j + 4, w, lane);
        sscan_step(S, r1, SSC, it0 + j + 1, w, lane); if (j + 5 < 32) sscan_load(r1, p, it0 + j + 5, w, lane);
        sscan_step(S, r2, SSC, it0 + j + 2, w, lane); if (j + 6 < 32) sscan_load(r2, p, it0 + j + 6, w, lane);
        sscan_step(S, r3, SSC, it0 + j + 3, w, lane); if (j + 7 < 32) sscan_load(r3, p, it0 + j + 7, w, lane);
    }
}
DI void hgrn_ointer(const Params& p, int bi) {
    const int tid = threadIdx.x, lane = tid & 63, w = __builtin_amdgcn_readfirstlane(tid >> 6), fr = lane & 15, fq = lane >> 4;
    const int it = 2 * bi + (w >> 2), tb = w & 3, bh = it >> 5, j = it & 31, b = bh >> 3, h = bh & 7;
    unsigned char* ws = p.ws;
    const bf16_t* QEg = (const bf16_t*)(ws + WS_QEG); const u32x4* SSC = (const u32x4*)(ws + WS_SSC); const bf16_t* SG = (const bf16_t*)(ws + WS_SG); bf16_t* YA = (bf16_t*)(ws + WS_YA);
    const u32x2* OIg = (const u32x2*)((unsigned char*)p.out + OUT_OI);
    const size_t rowo = ((size_t)b * SEQ + 64 * j + 16 * tb + fr) * 1024 + h * 128;
    bf16x8 qf[4];
#pragma unroll
    for (int ks = 0; ks < 4; ++ks) qf[ks] = __builtin_nontemporal_load((const bf16x8*)(QEg + rowo + 32 * ks + 8 * fq));
    u32x2 sg[8];
#pragma unroll
    for (int vb = 0; vb < 8; ++vb) sg[vb] = __builtin_nontemporal_load((const u32x2*)(SG + rowo + 16 * vb + 4 * fq));
    f32x4 o[8]; float ss = 0.f;
#pragma unroll
    for (int hf = 0; hf < 2; ++hf) {
        bf16x8 sf[4][4]; u32x2 oi[4];
#pragma unroll
        for (int v4 = 0; v4 < 4; ++v4) {
            oi[v4] = __builtin_nontemporal_load(OIg + ((size_t)(it * 8 + 2 * tb + hf) * 4 + v4) * 64 + lane);
#pragma unroll
            for (int ks = 0; ks < 4; ++ks) { const u32x4 t = SSC[((size_t)(it * 8 + 2 * ks + hf) * 4 + v4) * 64 + lane]; sf[v4][ks] = __builtin_bit_cast(bf16x8, t); }
        }
#pragma unroll
        for (int v4 = 0; v4 < 4; ++v4) { f32x4 a = (f32x4){bflo(oi[v4].x), bfhi(oi[v4].x), bflo(oi[v4].y), bfhi(oi[v4].y)};
#pragma unroll
            for (int ks = 0; ks < 4; ++ks) a = MFMA16(sf[v4][ks], qf[ks], a);
            o[4 * hf + v4] = a; ss += (a[0] * a[0] + a[1] * a[1]) + (a[2] * a[2] + a[3] * a[3]); }
    }
    ss += __shfl_xor(ss, 16); ss += __shfl_xor(ss, 32);
    const float rn = rsqrtf(ss * (1.f / 128.f) + EPS);
#pragma unroll
    for (int vb = 0; vb < 8; ++vb) {
        const f32x4 gn = *(const f32x4*)(p.in[6] + h * 128 + 16 * vb + 4 * fq); const u32x2 g = sg[vb];
        u32x2 y; y.x = pk2(o[vb][0] * rn * gn[0] * silu(bflo(g.x)), o[vb][1] * rn * gn[1] * silu(bfhi(g.x))); y.y = pk2(o[vb][2] * rn * gn[2] * silu(bflo(g.y)), o[vb][3] * rn * gn[3] * silu(bfhi(g.y)));
        *(u32x2*)(YA + rowo + 16 * vb + 4 * fq) = y;
    }
}

DI void norm_rows_to_lds(u32x4 r, const float* g8, float mul, LAS bf16_t* dst) {
    float v[8] = {bflo(r.x), bfhi(r.x), bflo(r.y), bfhi(r.y), bflo(r.z), bfhi(r.z), bflo(r.w), bfhi(r.w)};
    float s = 0.f;
#pragma unroll
    for (int i = 0; i < 8; ++i) s += v[i] * v[i];
    s += __shfl_xor(s, 1); s += __shfl_xor(s, 2); s += __shfl_xor(s, 4); s += __shfl_xor(s, 8);
    const float rs = rsqrtf(s * (1.f / 128.f) + EPS) * mul;
    u32x4 o; o.x = pk2(v[0] * rs * g8[0], v[1] * rs * g8[1]); o.y = pk2(v[2] * rs * g8[2], v[3] * rs * g8[3]); o.z = pk2(v[4] * rs * g8[4], v[5] * rs * g8[5]); o.w = pk2(v[6] * rs * g8[6], v[7] * rs * g8[7]);
    *(LAS u32x4*)dst = o;
}
DI void vt_to_lds(u32x4 r0, u32x4 r1, LAS bf16_t* VTb, int vg, int sp) {
    const unsigned a[4] = {r0.x, r0.y, r0.z, r0.w}, c[4] = {r1.x, r1.y, r1.z, r1.w};
#pragma unroll
    for (int i = 0; i < 4; ++i) {
        *(LAS unsigned*)(VTb + (8 * vg + 2 * i) * 72 + 2 * sp) = (a[i] & 0xffffu) | (c[i] << 16);
        *(LAS unsigned*)(VTb + (8 * vg + 2 * i + 1) * 72 + 2 * sp) = (a[i] >> 16) | (c[i] & 0xffff0000u);
    }
}
struct KvRegs { u32x4 k0, k1, v0, v1; };
DI void kv_load(KvRegs& r, const bf16_t* KBp, const bf16_t* VBp, size_t kt, int h, int srow, int spc, int sp, int vg) {
    r.k0 = *(const u32x4*)(KBp + (kt + srow) * 1024 + h * 128 + 8 * spc); r.k1 = *(const u32x4*)(KBp + (kt + srow + 32) * 1024 + h * 128 + 8 * spc);
    r.v0 = *(const u32x4*)(VBp + (kt + 2 * sp) * 1024 + h * 128 + 8 * vg); r.v1 = *(const u32x4*)(VBp + (kt + 2 * sp + 1) * 1024 + h * 128 + 8 * vg);
}
DI void kv_store(const KvRegs& r, LAS bf16_t* KLn, LAS bf16_t* VTn, const float* kg, int srow, int spc, int sp, int vg) {
    norm_rows_to_lds(r.k0, kg, 1.f, KLn + srow * 136 + 8 * spc); norm_rows_to_lds(r.k1, kg, 1.f, KLn + (srow + 32) * 136 + 8 * spc);
    vt_to_lds(r.v0, r.v1, VTn, vg, sp);
}
DI void attn_item(LAS unsigned char* L, const Params& p, int it) {
    const int tid = threadIdx.x, lane = tid & 63, w = __builtin_amdgcn_readfirstlane(tid >> 6), fr = lane & 15, fq = lane >> 4;
    const int mI = it >> 5, bh = it & 31, b = bh >> 3, h = bh & 7, n0 = 2 * mI, nq = n0 + (w >> 2);
    unsigned char* ws = p.ws;
    const bf16_t* QBp = (const bf16_t*)(ws + WS_QB); const bf16_t* KBp = (const bf16_t*)(ws + WS_KB); const bf16_t* VBp = (const bf16_t*)(ws + WS_VB); bf16_t* YB = (bf16_t*)(ws + WS_YB);
    LAS bf16_t* QL = (LAS bf16_t*)(L + 0);
    LAS bf16_t* KL0 = (LAS bf16_t*)(L + 34816);
    LAS bf16_t* VTL0 = (LAS bf16_t*)(L + 69632);
    LAS float* BIAS = (LAS float*)(L + 106496);
    const size_t tok0 = (size_t)b * SEQ + 64 * n0; const int c0 = n0 > 8 ? n0 - 8 : 0, nch = n0 + 2 - c0;
    const int srow = tid >> 4, spc = tid & 15, sp = tid & 31, vg = tid >> 5;
    if (tid < 191) BIAS[tid] = p.in[9][h * 191 + tid];
    float kg[8];
#pragma unroll
    for (int i = 0; i < 8; ++i) kg[i] = p.in[8][8 * spc + i];
    KvRegs RA, RB;
    {
        const size_t kt0 = (size_t)b * SEQ + 64 * c0;
        KvRegs R0; kv_load(R0, KBp, VBp, kt0, h, srow, spc, sp, vg);
        kv_load(RB, KBp, VBp, kt0 + 64, h, srow, spc, sp, vg);
        float qg[8];
#pragma unroll
        for (int i = 0; i < 8; ++i) qg[i] = p.in[7][8 * spc + i];
#pragma unroll
        for (int ps = 0; ps < 4; ++ps) { const int row = srow + 32 * ps;
            norm_rows_to_lds(__builtin_nontemporal_load((const u32x4*)(QBp + (tok0 + row) * 1024 + h * 128 + 8 * spc)), qg, 0.08838834764831845f, QL + row * 136 + 8 * spc); }
        kv_store(R0, KL0, VTL0, kg, srow, spc, sp, vg);
    }
    __syncthreads();
    bf16x8 qf[4];
#pragma unroll
    for (int ks = 0; ks < 4; ++ks) qf[ks] = ldfrag(QL, 136, 16 * w + fr, 32 * ks + 8 * fq);
    float mrow = -1e30f, lrow = 0.f;
    f32x4 O[8];
#pragma unroll
    for (int i = 0; i < 8; ++i) O[i] = (f32x4){0.f, 0.f, 0.f, 0.f};
    const int qpos = 64 * nq + 16 * (w & 3) + fr;
#define ATT_ITER(i_, LD, ST) do { const int i = (i_); const int c = c0 + i, buf = i & 1; \
        if (i + 2 < nch) kv_load(LD, KBp, VBp, (size_t)b * SEQ + 64 * (c + 2), h, srow, spc, sp, vg); \
        if (c <= nq && c + 8 >= nq) { \
            const LAS bf16_t* KLb = KL0 + buf * 8704; const LAS bf16_t* VTb = VTL0 + buf * 9216; \
            f32x4 s[4]; \
            _Pragma("unroll") for (int kb = 0; kb < 4; ++kb) { s[kb] = (f32x4){0.f, 0.f, 0.f, 0.f}; \
                _Pragma("unroll") for (int ks = 0; ks < 4; ++ks) s[kb] = MFMA16(ldfrag(KLb, 136, 16 * kb + fr, 32 * ks + 8 * fq), qf[ks], s[kb]); } \
            const int d0 = qpos - (64 * c + 4 * fq); float mx = -1e30f; \
            _Pragma("unroll") for (int kb = 0; kb < 4; ++kb) _Pragma("unroll") for (int jj = 0; jj < 4; ++jj) { int d = d0 - 16 * kb - jj; d = d > 127 ? 127 : d; s[kb][jj] += BIAS[d + 63]; mx = fmaxf(mx, s[kb][jj]); } \
            mx = fmaxf(mx, __shfl_xor(mx, 16)); mx = fmaxf(mx, __shfl_xor(mx, 32)); \
            const float mn = fmaxf(mrow, mx), alpha = __expf(mrow - mn); mrow = mn; float ps = 0.f; \
            _Pragma("unroll") for (int kb = 0; kb < 4; ++kb) _Pragma("unroll") for (int jj = 0; jj < 4; ++jj) { s[kb][jj] = __expf(s[kb][jj] - mn); ps += s[kb][jj]; } \
            lrow = lrow * alpha + ps; \
            const u32x4 pw0 = pack8(s[0], s[1]), pw1 = pack8(s[2], s[3]); const bf16x8 pf0 = __builtin_bit_cast(bf16x8, pw0), pf1 = __builtin_bit_cast(bf16x8, pw1); \
            _Pragma("unroll") for (int vb = 0; vb < 8; ++vb) { O[vb] *= alpha; const LAS bf16_t* vr = VTb + (16 * vb + fr) * 72 + 4 * fq; \
                const u32x2 a0 = *(const LAS u32x2*)(vr), a1 = *(const LAS u32x2*)(vr + 16), a2 = *(const LAS u32x2*)(vr + 32), a3 = *(const LAS u32x2*)(vr + 48); \
                const u32x4 v0 = (u32x4){a0.x, a0.y, a1.x, a1.y}, v1 = (u32x4){a2.x, a2.y, a3.x, a3.y}; \
                O[vb] = MFMA16(__builtin_bit_cast(bf16x8, v0), pf0, O[vb]); O[vb] = MFMA16(__builtin_bit_cast(bf16x8, v1), pf1, O[vb]); } \
        } \
        if (i + 1 < nch) kv_store(ST, KL0 + (buf ^ 1) * 8704, VTL0 + (buf ^ 1) * 9216, kg, srow, spc, sp, vg); \
        lds_barrier(); } while (0)
    for (int ii = 0; ii < nch; ii += 2) { ATT_ITER(ii, RA, RB); if (ii + 1 < nch) ATT_ITER(ii + 1, RB, RA); }
#undef ATT_ITER
    lrow += __shfl_xor(lrow, 16); lrow += __shfl_xor(lrow, 32);
    {
        const float inv = 1.f / lrow;
        const size_t o0 = (tok0 + 16 * w + fr) * 1024 + h * 128 + 4 * fq;
#pragma unroll
        for (int vb = 0; vb < 8; ++vb) { u32x2 y; y.x = pk2(O[vb][0] * inv, O[vb][1] * inv); y.y = pk2(O[vb][2] * inv, O[vb][3] * inv); *(u32x2*)(YB + o0 + 16 * vb) = y; }
    }
}

__global__ void __launch_bounds__(512, 2) fwd_kernel(Params p) {
    extern __shared__ __attribute__((aligned(16))) unsigned char lds_raw[];
    LAS unsigned char* L = (LAS unsigned char*)lds_raw;
    cg::grid_group grid = cg::this_grid();
    __shared__ __attribute__((aligned(16))) unsigned xb_st[4];
    if (threadIdx.x < 4) xb_st[threadIdx.x] = 0u;
    __syncthreads();
    const XcdBarrier xbar = xcd_barrier_post((unsigned*)(p.ws + WS_BAR), (volatile LAS unsigned*)xb_st);
    if (p.ph_hi > 64) grid.sync();
    const int G = gridDim.x, lo = p.ph_lo, hi = p.ph_hi;
    unsigned char* ws = p.ws;
#define IN(k) (lo <= (k) && (k) < hi)
#define GSYNC() xcd_barrier(xbar)
#define SEAM(k) do { if ((k) + 1 < hi) GSYNC(); } while (0)
#define NREP(k) ((PROBE_DUP == (k)) ? 2 : 1)
    const int p1rem = ((MTOK / 256) * (NIN / 256)) % G;
    const bool late_in_p1 = (p1rem != 0) && (2 * p1rem <= G) && IN(0) && IN(1);
    const bool late_in_p5 = late_in_p1 && IN(5);
    if (IN(0)) { for (int rep = 0; rep < NREP(0); ++rep) { p0_prologue(L, p, G, late_in_p1 ? I_IN : NITEMS); if (rep + 1 < NREP(0)) GSYNC(); } SEAM(0); }
    if (IN(1)) {
        pg8::SchedPlain S{(const char*)p.out, (const char*)(ws + WS_WIN), MTOK / 256, NIN / 256, DM, G, (int)blockIdx.x, WGM_P1};
        Epi1 E{(bf16_t*)(ws + WS_QS), (bf16_t*)(ws + WS_KK), (bf16_t*)(ws + WS_VI), (bf16_t*)(ws + WS_SG), (bf16_t*)(ws + WS_QB), (bf16_t*)(ws + WS_KB), (bf16_t*)(ws + WS_VB),
               (bf16_t*)(ws + WS_GA), (bf16_t*)(ws + WS_GB), (float*)(ws + WS_LOGF), p.in[5], p.in[2]};
        for (int rep = 0; rep < NREP(1); ++rep) { pg8::gemm_phase(L, DM, S, E); if (rep + 1 < NREP(1)) GSYNC(); }
        if (late_in_p1 && (int)blockIdx.x >= p1rem) convert_items(L, p, I_IN, late_in_p5 ? NITEMS - I_F2 : NITEMS, ((int)blockIdx.x - p1rem) * 8 + (int)(threadIdx.x >> 6), (G - p1rem) * 8);
        SEAM(1);
    }
    if (IN(2)) {
        {
            LocRegs ra, rb; int it = blockIdx.x;
            if (it < 1024) local_load(ra, p, it, threadIdx.x);
            for (; it < 1024; it += G) { const bool more = it + G < 1024; if (more) local_load(rb, p, it + G, threadIdx.x); hgrn_local(L, p, it, ra); if (more) ra = rb; }
        }
        GSYNC();
        if ((int)blockIdx.x < 32) hgrn_sscan(p, blockIdx.x);
        for (;;) {
            if (threadIdx.x == 0) xb_st[2] = atomicAdd((unsigned*)(ws + WS_QCTR), 1u);
            __syncthreads(); const unsigned it = xb_st[2]; __syncthreads();
            if (it >= 512u) break;
            attn_item(L, p, 511 - (int)it);
        }
        GSYNC();
        for (int bi = blockIdx.x; bi < 512; bi += G) hgrn_ointer(p, bi);
        SEAM(2);
    }
    if (IN(3)) {
        pg8::SchedDual S{(const char*)(ws + WS_YA), (const char*)(ws + WS_WPA), (const char*)(ws + WS_YB), (const char*)(ws + WS_WPB), MTOK / 256, DM / 256, DA, G, (int)blockIdx.x};
        Epi3 E{(const unsigned char*)(ws + WS_GA), (const unsigned char*)(ws + WS_GB), (bf16_t*)(ws + WS_MERGED)};
        for (int rep = 0; rep < NREP(3); ++rep) { pg8::gemm_phase(L, DA, S, E); if (rep + 1 < NREP(3)) GSYNC(); } SEAM(3);
    }
    if (IN(4)) {
        pg8::SchedPlain S{(const char*)(ws + WS_MERGED), (const char*)(ws + WS_WO), MTOK / 256, DM / 256, DM, G, (int)blockIdx.x, 4};
        Epi4 E{p.in[0], p.out, (bf16_t*)(ws + WS_X1B), (float*)(ws + WS_CTL)};
        pg8::gemm_phase(L, DM, S, E); SEAM(4);
    }
    if (IN(5)) {
        pg8::SchedPlain S{(const char*)(ws + WS_X1B), (const char*)(ws + WS_WF1), MTOK / 256, NIN / 256, DM, G, (int)blockIdx.x, WGM_P5};
        Epi5 E{(const float*)(ws + WS_CTL), (bf16_t*)(ws + WS_ACT)};
        for (int rep = 0; rep < NREP(5); ++rep) { pg8::gemm_phase(L, DM, S, E); if (rep + 1 < NREP(5)) GSYNC(); }
        if (late_in_p5 && (int)blockIdx.x >= p1rem) convert_items(L, p, NITEMS - I_F2, NITEMS, ((int)blockIdx.x - p1rem) * 8 + (int)(threadIdx.x >> 6), (G - p1rem) * 8);
        SEAM(5);
    }
    if (IN(6)) {
        pg8::SchedPlain S{(const char*)(ws + WS_ACT), (const char*)(ws + WS_WF2), MTOK / 256, DM / 256, DFF, G, (int)blockIdx.x, 4};
        Epi6 E{(const bf16_t*)(ws + WS_X1B), p.out};
        if (PROBE_DUP == 6) { EpiNull EN{(float*)(ws + WS_CTL) + 16000}; pg8::gemm_phase(L, DFF, S, EN); GSYNC(); }
        pg8::gemm_phase(L, DFF, S, E);
    }
#undef IN
#undef SEAM
}

extern "C" void kernel_launch(void* const* d_in, const int* in_sizes, int n_in, void* d_out, int out_size, void* d_ws, size_t ws_size, hipStream_t stream) {
    static int grid = 0;
    if (grid == 0) {
        if (n_in != 15 || out_size != MTOK * DM || ws_size < WS_END) { fprintf(stderr, "kernel_launch: unexpected shapes (n_in %d out %d ws %zu)\n", n_in, out_size, ws_size); grid = -1; return; }
        int dev = 0, cus = 0, per_cu = 0;
        hipGetDevice(&dev); hipDeviceGetAttribute(&cus, hipDeviceAttributeMultiprocessorCount, dev);
        if (hipFuncSetAttribute((const void*)fwd_kernel, hipFuncAttributeMaxDynamicSharedMemorySize, LDS_BYTES) != hipSuccess) { fprintf(stderr, "kernel_launch: hipFuncSetAttribute failed\n"); grid = -1; return; }
        if (hipOccupancyMaxActiveBlocksPerMultiprocessor(&per_cu, (const void*)fwd_kernel, 512, LDS_BYTES) != hipSuccess || per_cu < 1) { fprintf(stderr, "kernel_launch: occupancy query failed (%d)\n", per_cu); grid = -1; return; }
        grid = cus * per_cu;
    }
    if (grid < 0) return;
    if (hipMemsetAsync(d_ws, 0, 131072, stream) != hipSuccess) { fprintf(stderr, "kernel_launch: memset failed\n"); return; }
    Params p{};
    for (int i = 0; i < 15; ++i) p.in[i] = (const float*)d_in[i];
    p.out = (float*)d_out; p.ws = (unsigned char*)d_ws; p.ph_lo = 0; p.ph_hi = 7;
    void* args[] = {&p};
    hipError_t e = hipLaunchCooperativeKernel((const void*)fwd_kernel, dim3(grid), dim3(512), args, LDS_BYTES, stream);
    if (e != hipSuccess) fprintf(stderr, "cooperative launch failed: %s (grid %d)\n", hipGetErrorString(e), grid);
}
```
